# Optimizing an MI355X kernel written in HIP

```python
import math
import jax
import jax.numpy as jnp
from jax import lax
import numpy as np


D_MODEL = 1024
BATCH = 8
SEQ = 2048
DEPTH = 2

CTX_LEN = 256
GRID_W = 64

ML_HEADS = 4
ML_DH = D_MODEL // 16
ML_W = ML_HEADS * ML_DH
ML_CHUNK = 64
ML_M_INIT = -1e30
DA_HEADS = 4
DA_DH = D_MODEL // 16
DA_VD = 2 * DA_DH
DA_W = DA_HEADS * DA_VD
DA_QBLOCK = 128
ROPE_THETA = 10000.0
HY_W = D_MODEL // 4
HY_ORDER = 2
HY_BANDS = 8
HY_POS_DIM = 1 + 2 * HY_BANDS
HY_FFN = 64
HY_SHIFT = 0.05
HY_TARGET = 1e-2
HY_FAST = 0.3
HY_SLOW = 1.5
MIX_W = ML_W + DA_W + HY_W
ML_COLS = 4 * ML_W + 4 * ML_HEADS
DA_COLS = 3 * DA_W
HY_COLS = (HY_ORDER + 1) * HY_W
IN_COLS = ML_COLS + DA_COLS + HY_COLS
N_EXPERTS = 256
TOP_K = 8
N_GROUPS = 8
TOPK_GROUPS = 4
EXPERT_FF = D_MODEL // 4
SHARED_FF = EXPERT_FF
ROUTED_SCALE = 2.5
MOE_BLOCK = 128
EPS = 1e-6

kernel_name = 'hybrid_mlstm_diffattn_hyena_moe_dit'

F32 = jnp.float32


def rms_norm(x, g):
    xf = x.astype(F32)
    y = xf * lax.rsqrt(jnp.mean(xf * xf, axis=-1, keepdims=True) + EPS)
    return y.astype(x.dtype) * g


def axial_rope_tables(n_tokens):
    rows = n_tokens // GRID_W
    r = jnp.repeat(jnp.arange(rows, dtype=F32), GRID_W)
    col = jnp.tile(jnp.arange(GRID_W, dtype=F32), rows)
    n_freq = DA_DH // 4
    inv = ROPE_THETA ** (-jnp.arange(n_freq, dtype=F32) / n_freq)
    ar = r[:, None] * inv
    ac = col[:, None] * inv
    ang = jnp.concatenate([ar, ar, ac, ac], axis=-1)
    return jnp.cos(ang), jnp.sin(ang)


def apply_axial_rope(x, cos, sin):
    a1, a2, b1, b2 = jnp.split(x, 4, axis=-1)
    rot = jnp.concatenate([-a2, a1, -b2, b1], axis=-1)
    cos = cos[:, None, None, :].astype(x.dtype)
    sin = sin[:, None, None, :].astype(x.dtype)
    return x * cos + rot * sin


def mlstm_chunkwise(q, k, v, i_pre, f_pre, state):
    B, H, T, dh = q.shape
    nc = T // ML_CHUNK

    def chunks(a):
        return jnp.moveaxis(a.reshape((B, H, nc, ML_CHUNK) + a.shape[3:]), 2, 0)

    logf = jax.nn.log_sigmoid(f_pre)
    tril = jnp.tril(jnp.ones((ML_CHUNK, ML_CHUNK), dtype=bool))

    def step(carry, inp):
        C, n, m = carry
        qc, kc, vc, ic, lfc = inp
        b = jnp.cumsum(lfc, axis=-1)
        dmat = jnp.where(tril, b[..., :, None] - b[..., None, :] + ic[..., None, :], -jnp.inf)
        inter = b + m[..., None]
        m_t = jnp.maximum(inter, jnp.max(dmat, axis=-1))
        w = jnp.exp(dmat - m_t[..., None])
        s = jnp.einsum('bhtd,bhsd->bhts', qc, kc) * w
        carry_w = jnp.exp(inter - m_t)
        num = jnp.einsum('bhts,bhse->bhte', s, vc) + carry_w[..., None] * jnp.einsum('bhed,bhtd->bhte', C, qc)
        den = jnp.sum(s, axis=-1) + carry_w * jnp.einsum('bhd,bhtd->bht', n, qc)
        h = num / jnp.maximum(jnp.abs(den), jnp.exp(-m_t))[..., None]
        b_end = b[..., -1]
        g = b_end[..., None] - b + ic
        m_new = jnp.maximum(b_end + m, jnp.max(g, axis=-1))
        ws = jnp.exp(g - m_new[..., None])
        decay = jnp.exp(b_end + m - m_new)
        C_new = decay[..., None, None] * C + jnp.einsum('bhs,bhse,bhsd->bhed', ws, vc, kc)
        n_new = decay[..., None] * n + jnp.einsum('bhs,bhsd->bhd', ws, kc)
        return (C_new, n_new, m_new), h

    state, hs = lax.scan(step, state, (chunks(q), chunks(k), chunks(v), chunks(i_pre), chunks(logf)))
    h = jnp.moveaxis(hs, 0, 2).reshape(B, H, T, dh)
    return h, state


def mlstm_parse(u, gate_b):
    B, T, _ = u.shape
    q, k, v, o, gates = jnp.split(u, [ML_W, 2 * ML_W, 3 * ML_W, 4 * ML_W], axis=-1)

    def heads(a):
        return a.reshape(B, T, ML_HEADS, ML_DH).transpose(0, 2, 1, 3).astype(F32)

    gates = (gates + gate_b).astype(F32).reshape(B, T, 4, ML_HEADS).transpose(2, 0, 3, 1)
    return heads(q), heads(k) * (ML_DH ** -0.5), heads(v), heads(o), gates


def mlstm_finish(h, o, norm_g, dtype):
    B, H, T, dh = h.shape
    hn = rms_norm(h, norm_g.reshape(ML_HEADS, 1, ML_DH).astype(F32))
    y = jax.nn.sigmoid(o) * hn
    return y.transpose(0, 2, 1, 3).reshape(B, T, ML_W).astype(dtype)


def mlstm_mixer(ul, uc, gate_b, norm_g, need_ctx):
    ql, kl, vl, ol, gl = mlstm_parse(ul, gate_b)
    qc, kc, vc, oc, gc = mlstm_parse(uc, gate_b)
    B = ul.shape[0]
    init = (jnp.zeros((B, ML_HEADS, ML_DH, ML_DH), F32),
            jnp.zeros((B, ML_HEADS, ML_DH), F32),
            jnp.full((B, ML_HEADS), ML_M_INIT, F32))

    def flip(a):
        return jnp.flip(a, axis=2)

    h_cf, st_f = mlstm_chunkwise(qc, kc, vc, gc[0], gc[1], init)
    h_lf, _ = mlstm_chunkwise(ql, kl, vl, gl[0], gl[1], st_f)
    h_cb, st_b = mlstm_chunkwise(flip(qc), flip(kc), flip(vc), flip(gc[2]), flip(gc[3]), init)
    h_lb, _ = mlstm_chunkwise(flip(ql), flip(kl), flip(vl), flip(gl[2]), flip(gl[3]), st_b)
    out_l = mlstm_finish(h_lf + flip(h_lb), ol, norm_g, ul.dtype)
    out_c = mlstm_finish(h_cf + flip(h_cb), oc, norm_g, uc.dtype) if need_ctx else None
    return out_l, out_c


def diff_parse(u, qg, kg):
    B, T, _ = u.shape
    q, k, v = jnp.split(u, [DA_W, 2 * DA_W], axis=-1)
    q = rms_norm(q.reshape(B, T, DA_HEADS, 2, DA_DH), qg)
    k = rms_norm(k.reshape(B, T, DA_HEADS, 2, DA_DH), kg)
    v = v.reshape(B, T, DA_HEADS, DA_VD)
    return q, k, v


def diff_block(qb, k, v, lam):
    s = jnp.einsum('bhqmd,bhkmd->bhmqk', qb, k).astype(F32) * (DA_DH ** -0.5)
    a = jax.nn.softmax(s, axis=-1)
    a = a[:, :, 0] - lam * a[:, :, 1]
    return jnp.einsum('bhqk,bhkd->bhqd', a.astype(v.dtype), v)


def diff_finish(o, subln_g, lam_init):
    B, H, T, _ = o.shape
    o = rms_norm(o, subln_g) * (1.0 - lam_init)
    return jnp.moveaxis(o, 1, 2).reshape(B, T, DA_W)


def diff_attn_mixer(ul, uc, qg, kg, lam_p, subln_g, lam_init, cos, sin, need_ctx):
    ql, kl, vl = diff_parse(ul, qg, kg)
    qc, kc, vc = diff_parse(uc, qg, kg)
    ql = apply_axial_rope(ql, cos, sin)
    kl = apply_axial_rope(kl, cos, sin)
    ql, kl, vl, qc, kc, vc = [jnp.moveaxis(a, 1, 2) for a in (ql, kl, vl, qc, kc, vc)]
    lp = lam_p.astype(F32)
    lam = jnp.exp(jnp.sum(lp[0] * lp[1])) - jnp.exp(jnp.sum(lp[2] * lp[3])) + lam_init
    k_all = jnp.concatenate([kc, kl], axis=2)
    v_all = jnp.concatenate([vc, vl], axis=2)
    B, H, S = ql.shape[:3]
    nb = S // DA_QBLOCK
    qblocks = jnp.moveaxis(ql.reshape(B, H, nb, DA_QBLOCK, 2, DA_DH), 2, 0)
    ob = lax.map(lambda qb: diff_block(qb, k_all, v_all, lam), qblocks)
    o_l = jnp.moveaxis(ob, 0, 2).reshape(B, H, S, DA_VD)
    out_l = diff_finish(o_l, subln_g, lam_init)
    out_c = diff_finish(diff_block(qc, kc, vc, lam), subln_g, lam_init) if need_ctx else None
    return out_l, out_c


def short_conv(u, w, b):
    up = jnp.pad(u, ((0, 0), (1, 1), (0, 0)))
    return up[:, :-2] * w[0] + up[:, 1:-1] * w[1] + up[:, 2:] * w[2] + b


def hyena_filter_freq(L, w1, b1, w2, b2, w3, freq):
    t01 = jnp.linspace(0.0, 1.0, L, dtype=F32)[:, None]
    wpos = (2.0 * math.pi / L) * jnp.arange(L, dtype=F32)[:, None]
    bands = jnp.linspace(1e-4, HY_BANDS - 1, HY_BANDS, dtype=F32)
    feats = jnp.concatenate([t01, jnp.cos(wpos * bands), -jnp.sin(wpos * bands)], axis=-1)
    freq = freq.astype(F32)
    h = jnp.sin(freq[0] * (feats @ w1.astype(F32) + b1.astype(F32)))
    h = jnp.sin(freq[1] * (h @ w2.astype(F32) + b2.astype(F32)))
    h = (h @ w3.astype(F32)).reshape(L, HY_ORDER, 2, HY_W)
    deltas = jnp.abs(jnp.linspace(math.log(HY_TARGET) / HY_SLOW, math.log(HY_TARGET) / HY_FAST, HY_W, dtype=F32))
    h = h * (jnp.exp(-t01 * deltas) + HY_SHIFT)[:, None, None, :]
    hf, hb = h[:, :, 0], h[:, :, 1]
    kern = jnp.concatenate([hf[:1] + hb[:1], hf[1:], jnp.zeros_like(hf[:1]), hb[:0:-1]], axis=0)
    kern = kern * lax.rsqrt(jnp.sum(kern * kern, axis=0, keepdims=True) + EPS)
    return jnp.fft.rfft(kern, axis=0)


def long_conv(z, kf):
    L = z.shape[1]
    zf = jnp.fft.rfft(z.astype(F32), n=2 * L, axis=1)
    return jnp.fft.irfft(zf * kf[None], n=2 * L, axis=1)[:, :L].astype(z.dtype)


def hyena_seq(u, conv_w, conv_b, fw1, fb1, fw2, fb2, fw3, ffreq, skip):
    L = u.shape[1]
    u = short_conv(u, conv_w, conv_b)
    v, x1, x2 = jnp.split(u, 3, axis=-1)
    kf = hyena_filter_freq(L, fw1, fb1, fw2, fb2, fw3, ffreq)
    z = x1 * (long_conv(v, kf[:, 0]) + skip[0] * v)
    z = x2 * (long_conv(z, kf[:, 1]) + skip[1] * z)
    return z


def token_mixer(hl, hc, w_in, w_out, gate_b, ml_norm_g, qg, kg, lam_p, subln_g, lam_init, cos, sin,
                conv_w, conv_b, fw1, fb1, fw2, fb2, fw3, ffreq, skip, need_ctx):
    ul = hl @ w_in
    n_ctx_cols = IN_COLS if need_ctx else ML_COLS + DA_COLS
    uc = hc @ w_in[:, :n_ctx_cols]
    ml_l, da_l, hy_l = ul[..., :ML_COLS], ul[..., ML_COLS:ML_COLS + DA_COLS], ul[..., ML_COLS + DA_COLS:]
    ml_c, da_c = uc[..., :ML_COLS], uc[..., ML_COLS:ML_COLS + DA_COLS]
    m_l, m_c = mlstm_mixer(ml_l, ml_c, gate_b, ml_norm_g, need_ctx)
    d_l, d_c = diff_attn_mixer(da_l, da_c, qg, kg, lam_p, subln_g, lam_init, cos, sin, need_ctx)
    y_l = hyena_seq(hy_l, conv_w, conv_b, fw1, fb1, fw2, fb2, fw3, ffreq, skip)
    out_l = jnp.concatenate([m_l, d_l, y_l], axis=-1) @ w_out
    out_c = None
    if need_ctx:
        y_c = hyena_seq(uc[..., ML_COLS + DA_COLS:], conv_w, conv_b, fw1, fb1, fw2, fb2, fw3, ffreq, skip)
        out_c = jnp.concatenate([m_c, d_c, y_c], axis=-1) @ w_out
    return out_l, out_c


def routed_experts(h, top_idx, top_w, w1, w3, w2):
    T, D = h.shape
    E = w1.shape[0]
    A = T * TOP_K
    n_blocks = -(-(A + E * (MOE_BLOCK - 1)) // MOE_BLOCK)
    P = n_blocks * MOE_BLOCK
    flat_e = top_idx.reshape(-1)
    flat_tok = jnp.arange(A, dtype=jnp.int32) // TOP_K
    flat_w = top_w.reshape(-1)
    order = jnp.argsort(flat_e)
    sorted_e = flat_e[order]
    counts = jnp.bincount(flat_e, length=E)
    starts = jnp.cumsum(counts) - counts
    pcounts = (counts + MOE_BLOCK - 1) // MOE_BLOCK * MOE_BLOCK
    pends = jnp.cumsum(pcounts)
    pstarts = pends - pcounts
    dest = pstarts[sorted_e] + jnp.arange(A, dtype=jnp.int32) - starts[sorted_e]
    buf_tok = jnp.zeros((P,), jnp.int32).at[dest].set(flat_tok[order])
    buf_w = jnp.zeros((P,), h.dtype).at[dest].set(flat_w[order])
    block_e = jnp.minimum(jnp.searchsorted(pends, jnp.arange(n_blocks) * MOE_BLOCK, side='right'), E - 1)

    def body(acc, blk):
        tok, wt, e = blk
        xb = h[tok]
        yb = (jax.nn.silu(xb @ w1[e]) * (xb @ w3[e])) @ w2[e]
        return acc.at[tok].add(wt[:, None] * yb), None

    acc, _ = lax.scan(body, jnp.zeros_like(h),
                      (buf_tok.reshape(n_blocks, MOE_BLOCK), buf_w.reshape(n_blocks, MOE_BLOCK), block_e))
    return acc


def moe_ffn(h, router_w, router_b, ew1, ew3, ew2, sw1, sw3, sw2):
    T = h.shape[0]
    scores = jax.nn.sigmoid((h @ router_w).astype(F32))
    sel = scores + router_b.astype(F32)
    grp = sel.reshape(T, N_GROUPS, N_EXPERTS // N_GROUPS)
    grp_score = jnp.sum(lax.top_k(grp, 2)[0], axis=-1)
    _, gidx = lax.top_k(grp_score, TOPK_GROUPS)
    gmask = jnp.sum(jax.nn.one_hot(gidx, N_GROUPS, dtype=F32), axis=1) > 0
    sel = jnp.where(jnp.repeat(gmask, N_EXPERTS // N_GROUPS, axis=1), sel, -jnp.inf)
    _, idx = lax.top_k(sel, TOP_K)
    w = jnp.take_along_axis(scores, idx, axis=1)
    w = w / jnp.sum(w, axis=-1, keepdims=True) * ROUTED_SCALE
    routed = routed_experts(h, idx, w.astype(h.dtype), ew1, ew3, ew2)
    shared = (jax.nn.silu(h @ sw1) * (h @ sw3)) @ sw2
    return routed + shared


def setup_inputs(seed: int = 0) -> dict:
    key = jax.random.key(seed)
    ks = iter(jax.random.split(key, 48))
    L = DEPTH
    D = D_MODEL

    def nrm(shape, scale):
        return jax.random.normal(next(ks), shape, F32) * scale

    gate_b = jnp.concatenate([
        nrm((L, ML_HEADS), 0.1),
        jnp.linspace(3.0, 6.0, ML_HEADS, dtype=F32)[None] + nrm((L, ML_HEADS), 0.1),
        nrm((L, ML_HEADS), 0.1),
        jnp.linspace(3.0, 6.0, ML_HEADS, dtype=F32)[None] + nrm((L, ML_HEADS), 0.1)], axis=-1)
    return {
        'x': nrm((BATCH, SEQ, D), 1.0),
        'c': nrm((BATCH, D), 1.0),
        'ctx': nrm((BATCH, CTX_LEN, D), 1.0),
        'c_ctx': nrm((D,), 1.0),
        'w_mod': nrm((L, D, 6 * D), 0.5 * D ** -0.5),
        'b_mod': nrm((L, 6 * D), 0.02),
        'norm1_g': 1.0 + nrm((L, D), 0.02),
        'norm2_g': 1.0 + nrm((L, D), 0.02),
        'w_in': nrm((L, D, IN_COLS), D ** -0.5),
        'mlstm_gate_b': gate_b,
        'mlstm_norm_g': 1.0 + nrm((L, ML_W), 0.02),
        'da_qnorm_g': 1.0 + nrm((L, DA_DH), 0.02),
        'da_knorm_g': 1.0 + nrm((L, DA_DH), 0.02),
        'da_lambda': nrm((L, 4, DA_DH), 0.1),
        'da_subln_g': 1.0 + nrm((L, DA_VD), 0.02),
        'hy_conv_w': nrm((L, 3, HY_COLS), 3 ** -0.5),
        'hy_conv_b': nrm((L, HY_COLS), 0.02),
        'hy_w1': nrm((L, HY_POS_DIM, HY_FFN), HY_POS_DIM ** -0.5),
        'hy_b1': nrm((L, HY_FFN), 0.1),
        'hy_w2': nrm((L, HY_FFN, HY_FFN), HY_FFN ** -0.5),
        'hy_b2': nrm((L, HY_FFN), 0.1),
        'hy_w3': nrm((L, HY_FFN, HY_ORDER * 2 * HY_W), HY_FFN ** -0.5),
        'hy_freq': 1.0 + nrm((L, 2, HY_FFN), 0.02),
        'hy_skip': nrm((L, HY_ORDER, HY_W), 1.0),
        'w_out': nrm((L, MIX_W, D), MIX_W ** -0.5),
        'router_w': nrm((L, D, N_EXPERTS), D ** -0.5),
        'router_b': nrm((L, N_EXPERTS), 0.01),
        'exp_w1': nrm((L, N_EXPERTS, D, EXPERT_FF), D ** -0.5),
        'exp_w3': nrm((L, N_EXPERTS, D, EXPERT_FF), D ** -0.5),
        'exp_w2': nrm((L, N_EXPERTS, EXPERT_FF, D), EXPERT_FF ** -0.5),
        'sh_w1': nrm((L, D, SHARED_FF), D ** -0.5),
        'sh_w3': nrm((L, D, SHARED_FF), D ** -0.5),
        'sh_w2': nrm((L, SHARED_FF, D), SHARED_FF ** -0.5),
    }


def reference(x, c, ctx, c_ctx, w_mod, b_mod, norm1_g, norm2_g, w_in, mlstm_gate_b, mlstm_norm_g,
              da_qnorm_g, da_knorm_g, da_lambda, da_subln_g, hy_conv_w, hy_conv_b, hy_w1, hy_b1,
              hy_w2, hy_b2, hy_w3, hy_freq, hy_skip, w_out, router_w, router_b, exp_w1, exp_w3,
              exp_w2, sh_w1, sh_w3, sh_w2):
    B, S, D = x.shape
    n_ctx = ctx.shape[1]
    cos, sin = axial_rope_tables(S)
    xl, xc = x, ctx
    sc = jax.nn.silu(c)
    scc = jax.nn.silu(c_ctx)
    for l in range(DEPTH):
        last = l == DEPTH - 1
        lam_init = 0.8 - 0.6 * math.exp(-0.3 * l)
        sh1, s1, g1, sh2, s2, g2 = [m[:, None, :] for m in jnp.split(sc @ w_mod[l] + b_mod[l], 6, axis=-1)]
        csh1, cs1, cg1, csh2, cs2, cg2 = jnp.split(scc @ w_mod[l] + b_mod[l], 6, axis=-1)
        hl = rms_norm(xl, norm1_g[l]) * (1.0 + s1) + sh1
        hc = rms_norm(xc, norm1_g[l]) * (1.0 + cs1) + csh1
        ol, oc = token_mixer(hl, hc, w_in[l], w_out[l], mlstm_gate_b[l], mlstm_norm_g[l],
                             da_qnorm_g[l], da_knorm_g[l], da_lambda[l], da_subln_g[l], lam_init, cos, sin,
                             hy_conv_w[l], hy_conv_b[l], hy_w1[l], hy_b1[l], hy_w2[l], hy_b2[l], hy_w3[l],
                             hy_freq[l], hy_skip[l], not last)
        xl = xl + g1 * ol
        h2l = rms_norm(xl, norm2_g[l]) * (1.0 + s2) + sh2
        if last:
            tokens = h2l.reshape(B * S, D)
        else:
            xc = xc + cg1 * oc
            h2c = rms_norm(xc, norm2_g[l]) * (1.0 + cs2) + csh2
            tokens = jnp.concatenate([h2l.reshape(B * S, D), h2c.reshape(B * n_ctx, D)], axis=0)
        y = moe_ffn(tokens, router_w[l], router_b[l], exp_w1[l], exp_w3[l], exp_w2[l],
                    sh_w1[l], sh_w3[l], sh_w2[l])
        xl = xl + g2 * y[:B * S].reshape(B, S, D)
        if not last:
            xc = xc + cg2 * y[B * S:].reshape(B, n_ctx, D)
    return xl
```

```cpp
#include <hip/hip_runtime.h>
#include <hip/hip_bf16.h>
#include <cstdint>
#include <cstdio>

#ifndef MK_PER_PHASE
#define MK_PER_PHASE 0
#endif

constexpr int D = 1024, NB = 8, SEQ = 2048, CTX = 256, TB = SEQ + CTX  , T = NB * TB  ;
constexpr int NPAN = T / 256;
constexpr int NU = 3328;
constexpr int U_DA = 1024, U_HY = 2560;
constexpr int INC = 3344;
constexpr int NE = 256, TOPK = 8, EFF = 256;
constexpr int NTHR = 512;
constexpr float EPS = 1e-6f;
constexpr int LDS_BYTES = 147456;

typedef unsigned short bf16_t;
typedef short bf16x8 __attribute__((ext_vector_type(8)));
typedef short s16x4 __attribute__((ext_vector_type(4)));
typedef float f32x4 __attribute__((ext_vector_type(4)));
typedef float f32x8 __attribute__((ext_vector_type(8)));
typedef float f32x16 __attribute__((ext_vector_type(16)));
typedef unsigned u32x4 __attribute__((ext_vector_type(4)));
typedef unsigned u32x2 __attribute__((ext_vector_type(2)));
typedef int i32x2 __attribute__((ext_vector_type(2)));
typedef int i32x4 __attribute__((ext_vector_type(4)));

constexpr size_t al256(size_t x) { return (x + 255) / 256 * 256; }
constexpr size_t WS_CTL   = 0;
constexpr size_t CTL_BAR_BYTES = 16384;
constexpr size_t CTL_CNT  = CTL_BAR_BYTES;
constexpr size_t CTL_WQ = CTL_BAR_BYTES + 2 * 256 * 4 + 64 * 8;
constexpr size_t CTL_BYTES = CTL_WQ + 8 * 256;
constexpr size_t WS_MODV  = al256(WS_CTL + CTL_BYTES);
constexpr size_t WS_WG    = al256(WS_MODV + 2 * 9 * 6144 * 4);
constexpr size_t WS_HYT   = al256(WS_WG + 2 * 16 * 1024 * 4);
constexpr size_t WS_PAR   = al256(WS_HYT + 2 * 2304 * 64 * 4);
constexpr int PAR_N1G = 0, PAR_N2G = 2048, PAR_MLGB = 4096, PAR_MLNG = 4128, PAR_DAQG = 4640, PAR_DAKG = 4768, PAR_DALAM = 4896, PAR_DASUB = 5408, PAR_HYCW = 5664, PAR_HYCB = 10272,
              PAR_HYSKIP = 11808, PAR_RB = 12832, PAR_HYW3 = 13344, PAR_RW = 144416, PAR_ROPER = 668704  , PAR_ROPEC = 669728  , PAR_END = 671776;
constexpr size_t WS_KF    = al256(WS_PAR + (size_t)PAR_END * 4);
constexpr size_t WS_WIN   = al256(WS_KF + (size_t)2 * 2 * 256 * 4096 * 4);
constexpr size_t WS_WOUT  = al256(WS_WIN + (size_t)2 * NU * D * 2);
constexpr size_t WS_WSH13 = al256(WS_WOUT + (size_t)2 * D * D * 2);
constexpr size_t WS_WSH2  = al256(WS_WSH13 + (size_t)2 * 512 * D * 2);
constexpr size_t WS_WE13  = al256(WS_WSH2 + (size_t)2 * D * 256 * 2);
constexpr size_t WS_WE2   = al256(WS_WE13 + (size_t)2 * NE * 512 * D * 2);
constexpr size_t WS_XL    = al256(WS_WE2 + (size_t)2 * NE * D * 256 * 2);
constexpr size_t WS_H     = al256(WS_XL + (size_t)T * D * 4);
constexpr size_t WS_GATE  = al256(WS_H + (size_t)T * D * 2);
constexpr size_t WS_WSLOT = al256(WS_GATE + (size_t)2 * T * 16 * 4);
constexpr size_t WS_EIDX  = al256(WS_WSLOT + (size_t)T * 8 * 4);
constexpr size_t WS_H2X   = al256(WS_EIDX + (size_t)T * 8 * 4);
constexpr size_t WS_LOG   = al256(WS_H2X + (size_t)T * 2048 * 2);
constexpr size_t WS_WR    = al256(WS_LOG + (size_t)T * 256 * 4);
constexpr size_t WS_ALIAS = al256(WS_WR + (size_t)2 * 256 * 3072 * 2);
constexpr size_t WS_U     = WS_ALIAS;
constexpr size_t USZ = (size_t)T * NU * 2;
constexpr size_t WS_QN    = al256(WS_U + USZ);
constexpr size_t WS_KN    = al256(WS_QN + (size_t)NB * 8 * TB * 64 * 2);
constexpr size_t WS_O     = al256(WS_KN + (size_t)NB * 8 * TB * 64 * 2);
constexpr size_t WS_HF    = al256(WS_O + (size_t)T * D * 4);
constexpr size_t WS_HB    = al256(WS_HF + (size_t)T * 256 * 4);
constexpr size_t WS_MIX   = al256(WS_HB + (size_t)T * 256 * 4);
constexpr size_t WS_HYO   = al256(WS_MIX + (size_t)T * D * 2);
constexpr size_t WS_UH    = al256(WS_HYO + (size_t)T * 256 * 4);
constexpr size_t WS_A_END = al256(WS_UH + (size_t)768 * T * 2);
constexpr int GROWS = T * TOPK + NE * 256;
constexpr size_t WS_G     = WS_ALIAS;
constexpr size_t WS_Y     = al256(WS_G + (size_t)GROWS * 256 * 2);
constexpr size_t WS_YSH   = al256(WS_Y + (size_t)(T * 8 + 256) * D * 2);
constexpr size_t WS_GSH   = al256(WS_YSH + (size_t)T * D * 2);
constexpr size_t WS_LIST  = al256(WS_GSH + (size_t)T * 256 * 2);
constexpr size_t WS_HIST  = al256(WS_LIST + (size_t)NE * T * 8);
constexpr size_t WS_B_END = al256(WS_HIST + (size_t)512 * NE * 4);
constexpr size_t WS_END   = WS_A_END > WS_B_END ? WS_A_END : WS_B_END;

__device__ __forceinline__ bf16_t f2bf(float x) { unsigned u = __float_as_uint(x); u += 0x7fffu + ((u >> 16) & 1u); return (bf16_t)(u >> 16); }
__device__ __forceinline__ float bf2f(bf16_t h) { return __uint_as_float(((unsigned)h) << 16); }
__device__ __forceinline__ unsigned cvtpk(float lo, float hi) { unsigned r; asm volatile("v_cvt_pk_bf16_f32 %0, %1, %2" : "=v"(r) : "v"(lo), "v"(hi)); return r; }
__device__ __forceinline__ float shx(float v, int off, int lane) { return __int_as_float(__builtin_amdgcn_ds_bpermute((lane ^ off) << 2, __float_as_int(v))); }
__device__ __forceinline__ int shx(int v, int off, int lane) { return __builtin_amdgcn_ds_bpermute((lane ^ off) << 2, v); }
__device__ __forceinline__ float shi(float v, int src) { return __int_as_float(__builtin_amdgcn_ds_bpermute(src << 2, __float_as_int(v))); }
__device__ __forceinline__ float shup(float v, int o, int lane) { return __int_as_float(__builtin_amdgcn_ds_bpermute((lane - o) << 2, __float_as_int(v))); }
template <int CTRL> __device__ __forceinline__ float dpp_f(float v) { return __int_as_float(__builtin_amdgcn_update_dpp(0, __float_as_int(v), CTRL, 0xf, 0xf, false)); }
__device__ __forceinline__ float rowsum16(float v) { v += dpp_f<0x128>(v); v += dpp_f<0x124>(v); v += dpp_f<0x122>(v); v += dpp_f<0x121>(v); return v; }
__device__ __forceinline__ float sum8(float v) { v += dpp_f<0xB1>(v); v += dpp_f<0x4E>(v); v += dpp_f<0x141>(v); return v; }
__device__ __forceinline__ float fexp(float x) { return __builtin_amdgcn_exp2f(x * 1.4426950408889634f); }
__device__ __forceinline__ float wsum(float v, int lane) { for (int o = 32; o >= 1; o >>= 1) v += shx(v, o, lane); return v; }
__device__ __forceinline__ float sigmoidf_(float x) { return 1.f / (1.f + __expf(-x)); }
__device__ __forceinline__ float siluf_(float x) { return x / (1.f + __expf(-x)); }

#define XB_TMO      128
#define XB_XCNT(j)  (256  + 64 * (j))
#define XB_XSUB(j)  (1280 + 64 * (j))
#define XB_XGEN(j)  (2304 + 64 * (j))
#define XB_TOP      3328
#define XB_TOPGEN   3392
#define XCD_BAR_WORDS 3456
#define XB_SPIN_CAP (1u << 18)
#define LAS __attribute__((address_space(3)))
__device__ __forceinline__ unsigned xb_ld(unsigned* p)              { return __hip_atomic_load(p, __ATOMIC_RELAXED, __HIP_MEMORY_SCOPE_AGENT); }
__device__ __forceinline__ unsigned xb_add(unsigned* p, unsigned v) { return __hip_atomic_fetch_add(p, v, __ATOMIC_RELAXED, __HIP_MEMORY_SCOPE_AGENT); }
__device__ __forceinline__ unsigned xb_xcc_id() { return (unsigned)__builtin_amdgcn_s_getreg((3 << 11) | 20) & 0xFu; }
#define XB_SPIN(cond, bar) do { unsigned _sp = 0; while (cond) { __builtin_amdgcn_s_sleep(1); \
    if ((++_sp & 255u) == 0u) { if (xb_ld(&(bar)[XB_TMO])) break; if (_sp > XB_SPIN_CAP) { atomicAdd(&(bar)[XB_TMO], 1u); break; } } } } while (0)
struct XcdBarrier { unsigned* bar; unsigned x; volatile LAS unsigned* st; };
__device__ __forceinline__ XcdBarrier xcd_barrier_post(unsigned* bar, volatile LAS unsigned* st) {
    XcdBarrier b; b.bar = bar; b.x = xb_xcc_id(); b.st = st;
    if (threadIdx.x == 0) (void)xb_add(&bar[XB_XCNT(b.x)], 1u);
    return b;
}
__device__ __forceinline__ void xcd_barrier_complete(unsigned* bar, unsigned x, unsigned& nloc, unsigned& nx) {
    const unsigned G = gridDim.x * gridDim.y * gridDim.z;
    unsigned sum, cnt, mine, sp = 0u;
    for (;;) {
        sum = 0u; cnt = 0u; mine = 0u;
#pragma unroll
        for (unsigned j = 0; j < 16; ++j) { const unsigned c = xb_ld(&bar[XB_XCNT(j)]); sum += c; cnt += (c > 0u) ? 1u : 0u; mine = (j == x) ? c : mine; }
        if (sum == G) break;
        __builtin_amdgcn_s_sleep(1);
        if ((++sp & 255u) == 0u) { if (xb_ld(&bar[XB_TMO])) break; if (sp > XB_SPIN_CAP) { atomicAdd(&bar[XB_TMO], 1u); break; } }
    }
    nloc = mine > 0u ? mine : 1u; nx = cnt > 0u ? cnt : 1u;
}
__device__ __forceinline__ void xcd_barrier(const XcdBarrier& b) {
    asm volatile("s_waitcnt vmcnt(0)" ::: "memory");
    __syncthreads();
    if (threadIdx.x == 0) {
        unsigned* bar = b.bar;
        __builtin_amdgcn_s_waitcnt(0);
        unsigned nloc = b.st[0], nx = b.st[1];
        if (nloc == 0u) { xcd_barrier_complete(bar, b.x, nloc, nx); b.st[0] = nloc; b.st[1] = nx; }
        const unsigned old = xb_add(&bar[XB_XSUB(b.x)], 1u);
        const unsigned gen = old / nloc;
        if (old + 1u == (gen + 1u) * nloc) {
            __builtin_amdgcn_fence(__ATOMIC_RELEASE, "agent");
            asm volatile("s_waitcnt vmcnt(0)" ::: "memory");
            const unsigned og = xb_add(&bar[XB_TOP], 1u);
            const unsigned tg = og / nx;
            if (og + 1u == (tg + 1u) * nx) xb_add(&bar[XB_TOPGEN], 1u);
            else XB_SPIN(xb_ld(&bar[XB_TOPGEN]) == tg, bar);
            __builtin_amdgcn_fence(__ATOMIC_ACQUIRE, "agent");
            xb_add(&bar[XB_XGEN(b.x)], 1u);
            asm volatile("s_waitcnt vmcnt(0)" ::: "memory");
        } else {
            XB_SPIN(xb_ld(&bar[XB_XGEN(b.x)]) == gen, bar);
            __builtin_amdgcn_fence(__ATOMIC_ACQUIRE, "agent");
            asm volatile("s_waitcnt vmcnt(0)" ::: "memory");
        }
    }
    __syncthreads();
}

struct Args { const float* in[33]; float* out; unsigned char* ws; int ph_lo, ph_hi; };
struct Frame {
    const float* x; const float* ctx; const float* ew1; const float* ew3; const float* ew2; float* out; unsigned char* ws; char* lds;
    int tid, lane, wave, G, bid;
};
enum { I_X = 0, I_C, I_CTX, I_CCTX, I_WMOD, I_BMOD, I_N1G, I_N2G, I_WIN, I_MLGB, I_MLNG, I_DAQG, I_DAKG, I_DALAM, I_DASUB, I_HYCW, I_HYCB,
       I_HYW1, I_HYB1, I_HYW2, I_HYB2, I_HYW3, I_HYFREQ, I_HYSKIP, I_WOUT, I_RW, I_RB, I_EW1, I_EW3, I_EW2, I_SW1, I_SW3, I_SW2 };
template <class Tp> __device__ __forceinline__ Tp* wsp(const Frame& F, size_t off) { return (Tp*)(F.ws + off); }
__device__ __forceinline__ const float* par(const Frame& F, int off) { return (const float*)(F.ws + WS_PAR) + off; }
__device__ __forceinline__ Frame phase_frame(const Frame& F0) { Frame F = F0; int t = threadIdx.x; asm volatile("" : "+v"(t)); F.tid = t; F.lane = t & 63; F.wave = __builtin_amdgcn_readfirstlane(t >> 6);
    __attribute__((address_space(1))) unsigned char* w = (__attribute__((address_space(1))) unsigned char*)F0.ws; asm volatile("" : "+s"(w)); F.ws = (unsigned char*)w;
    unsigned lb = (unsigned)(uintptr_t)(LAS char*)F0.lds; asm volatile("" : "+s"(lb)); F.lds = (char*)(LAS char*)(uintptr_t)lb; return F; }

namespace g8 {
constexpr int BM = 256, BK = 64, HALF = 128, HT = HALF * BK;
__device__ __forceinline__ int lds_byte(int r, int c) { int st = (r >> 4) * 2 + (c >> 5), rr = r & 15, cc = c & 31, ob = rr * 64 + cc * 2; return st * 1024 + (ob ^ (((ob >> 9) & 1) << 5)); }
__device__ __forceinline__ void stage_rc(int b, int& R, int& C) { int st = b / 1024, sb = b % 1024, swz = sb ^ (((sb >> 9) & 1) << 5); R = (st >> 1) * 16 + swz / 64; C = (st & 1) * 32 + (swz % 64) / 2; }
__device__ __forceinline__ int perm32(int rho) { const int n = rho >> 4, i = rho & 15; return 8 * (i >> 2) + 4 * n + (i & 3); }
__device__ __forceinline__ int stage_row(int t, int i) { int R, C; stage_rc(t * 16 + i * 8192, R, C); return R; }

struct GU { const bf16_t* A; const bf16_t* Bt; int arow0, pk0, pk1; };
template <int N> __device__ __forceinline__ void wait_v() { asm volatile("s_waitcnt vmcnt(%0)" :: "n"(N) : "memory"); }
template <bool GATHER, int AWRAP = 0, bool TR = true, int NCT = 1, int PST = 0, class Epi>
__device__ __forceinline__ void gemm256(char* shmc, const GU& cur, const int lda, const int K, const Epi& epi, const bool prefetched, const bool has_next, const GU& nxt) {
    bf16_t* shm = (bf16_t*)shmc;
#define SA(b,h) (shm+((b)*2+(h))*HT)
#define SB(b,h) (shm+(4+(b)*2+(h))*HT)
#define STAGE_A(T,P,h,kt,U_) do{ int _pk = (h) ? U_.pk1 : U_.pk0; if (GATHER) asm volatile("" : "+v"(_pk));     \
    for(int _i=0;_i<2;++_i){int _b=(T)*16+_i*8192;int _r,_c;stage_rc(_b,_r,_c); \
      const long _ro = GATHER ? (long)(_i ? (_pk >> 16) : (_pk & 0xffff))*lda : (long)(U_.arow0+(h)*HALF+_r)*lda; \
      const int _ka = NCT > 1 ? ((kt) & (ntk - 1)) : ((AWRAP && (kt) >= AWRAP) ? (kt) - AWRAP : (kt)); \
      __builtin_amdgcn_global_load_lds((const unsigned*)(U_.A+_ro+(long)_ka*BK+_c),(unsigned*)((char*)(P)+_b),16,0,0);}}while(0)
#define STAGE_B(T,P,h,kt,U_) do{ for(int _i=0;_i<2;++_i){int _b=(T)*16+_i*8192;int _r,_c;stage_rc(_b,_r,_c); \
      const long _kb = NCT > 1 ? (long)((kt) / ntk) * 256 * K + (long)((kt) & (ntk - 1)) * BK : (long)(kt) * BK; \
      const int _rs = TR ? ((_r & ~31) | perm32(_r & 31)) : _r; \
      __builtin_amdgcn_global_load_lds((const unsigned*)(U_.Bt+(long)((h)*HALF+_rs)*K+_kb+_c),(unsigned*)((char*)(P)+_b),16,0,0);}}while(0)
#define STAGE_FIRST2(T,U_) do{ STAGE_B(T, SB(0,0), 0, 0, U_); SCHED; STAGE_A(T, SA(0,0), 0, 0, U_); SCHED; STAGE_B(T, SB(0,1), 1, 0, U_); SCHED; STAGE_A(T, SA(0,1), 1, 0, U_); SCHED; \
      STAGE_B(T, SB(1,0), 0, 1, U_); SCHED; STAGE_A(T, SA(1,0), 0, 1, U_); SCHED; STAGE_B(T, SB(1,1), 1, 1, U_); SCHED; }while(0)
#define STAGE_T0(T,U_) do{ STAGE_B(T, SB(0,0), 0, 0, U_); SCHED; STAGE_A(T, SA(0,0), 0, 0, U_); SCHED; STAGE_B(T, SB(0,1), 1, 0, U_); SCHED; STAGE_A(T, SA(0,1), 1, 0, U_); SCHED; }while(0)
#define STAGE_T1(T,U_) do{ STAGE_B(T, SB(1,0), 0, 1, U_); SCHED; STAGE_A(T, SA(1,0), 0, 1, U_); SCHED; STAGE_B(T, SB(1,1), 1, 1, U_); SCHED; }while(0)
#define LDA(dst,b,h) for(int m=0;m<4;++m)for(int k=0;k<2;++k) \
    dst[m][k]=*reinterpret_cast<const bf16x8*>((char*)SA(b,h)+lds_byte(wr*64+m*16+fr,k*32+fq*8))
#define LDB(dst,b,h) for(int n=0;n<2;++n)for(int k=0;k<2;++k) \
    dst[n][k]=*reinterpret_cast<const bf16x8*>((char*)SB(b,h)+lds_byte(wc*32+n*16+fr,k*32+fq*8))
#define MMA(ai,bj,At,Bq) do{__builtin_amdgcn_s_setprio(1); \
    for(int m=0;m<4;++m)for(int n=0;n<2;++n)for(int k=0;k<2;++k) \
      acc[ai][bj][m][n]=TR ? __builtin_amdgcn_mfma_f32_16x16x32_bf16(Bq[n][k],At[m][k],acc[ai][bj][m][n],0,0,0) : __builtin_amdgcn_mfma_f32_16x16x32_bf16(At[m][k],Bq[n][k],acc[ai][bj][m][n],0,0,0); \
    __builtin_amdgcn_s_setprio(0);}while(0)
#define WAIT_V(n) asm volatile("s_waitcnt vmcnt(" #n ")":::"memory")
#define WAIT_L(n) asm volatile("s_waitcnt lgkmcnt(" #n ")":::"memory")
#define BAR __builtin_amdgcn_s_barrier()
#define SCHED __builtin_amdgcn_sched_barrier(0)
    int tx = threadIdx.x; asm volatile("" : "+v"(tx));
    int wid = tx >> 6, lane = tx & 63, wr = wid >> 2, wc = wid & 3, fr = lane & 15, fq = lane >> 4;
    f32x4 acc[2][2][4][2] = {};
    bf16x8 At[4][2], B0[2][2], B1[2][2];
    const int ntk = K / BK, nt = NCT * ntk;
    if (!prefetched) { STAGE_FIRST2(tx, cur); WAIT_V(0); } else wait_v<PST + 6>();
    if (wr == 1) BAR;
    BAR;
#pragma unroll 1
    for (int t = 0; t < nt - 2; t += 2) {
        LDB(B0,0,0); SCHED; LDA(At,0,0); STAGE_A(tx, SA(1,1), 1, t+1, cur);
        WAIT_L(8); BAR; WAIT_L(0); MMA(0,0,At,B0); BAR; SCHED;
        LDB(B1,0,1); STAGE_B(tx, SB(0,0), 0, t+2, cur);
        BAR; WAIT_L(0); MMA(0,1,At,B1); BAR;
        LDA(At,0,1); STAGE_A(tx, SA(0,0), 0, t+2, cur);
        BAR; WAIT_L(0); MMA(1,0,At,B0); BAR; SCHED;
        STAGE_B(tx, SB(0,1), 1, t+2, cur);
        WAIT_V(6); BAR; MMA(1,1,At,B1); BAR;
        LDB(B0,1,0); SCHED; LDA(At,1,0); STAGE_A(tx, SA(0,1), 1, t+2, cur);
        WAIT_L(8); BAR; WAIT_L(0); MMA(0,0,At,B0); BAR; SCHED;
        LDB(B1,1,1); STAGE_B(tx, SB(1,0), 0, t+3, cur);
        BAR; WAIT_L(0); MMA(0,1,At,B1); BAR;
        LDA(At,1,1); STAGE_A(tx, SA(1,0), 0, t+3, cur);
        BAR; WAIT_L(0); MMA(1,0,At,B0); BAR; SCHED;
        STAGE_B(tx, SB(1,1), 1, t+3, cur);
        WAIT_V(6); BAR; MMA(1,1,At,B1); BAR;
        if (NCT > 1 && ((t + 2) & (ntk - 1)) == 0) {
            epi(acc, wr, wc, fr, fq, t / ntk, epi.pre(wr, wc, fr, fq));
#pragma unroll
            for (int i0 = 0; i0 < 2; ++i0)
#pragma unroll
            for (int i1 = 0; i1 < 2; ++i1)
#pragma unroll
            for (int i2 = 0; i2 < 4; ++i2)
#pragma unroll
            for (int i3 = 0; i3 < 2; ++i3) acc[i0][i1][i2][i3] = (f32x4){0.f, 0.f, 0.f, 0.f}; }
    }
    int tz = threadIdx.x; asm volatile("" : "+v"(tz)); wid = tz >> 6; lane = tz & 63; wr = wid >> 2; wc = wid & 3; fr = lane & 15; fq = lane >> 4;
    { LDB(B0,0,0); LDA(At,0,0); STAGE_A(tz, SA(1,1), 1, nt-1, cur);
      BAR; WAIT_L(0); MMA(0,0,At,B0); BAR;
      LDB(B1,0,1); BAR; WAIT_L(0); MMA(0,1,At,B1); BAR;
      LDA(At,0,1); WAIT_V(4); BAR; WAIT_L(0); MMA(1,0,At,B0); MMA(1,1,At,B1); BAR; }
    { LDB(B0,1,0); LDA(At,1,0); WAIT_V(2); BAR; WAIT_L(0); MMA(0,0,At,B0);
      if (has_next) { int tn = threadIdx.x; asm volatile("" : "+v"(tn)); STAGE_T0(tn, nxt); }
      BAR;
      LDB(B1,1,1); if (has_next) WAIT_V(8); else WAIT_V(0); BAR; WAIT_L(0); MMA(0,1,At,B1); BAR;
      LDA(At,1,1); BAR; WAIT_L(0); MMA(1,0,At,B0); MMA(1,1,At,B1); BAR; }
    if (wr == 0) BAR;
    typename Epi::Pre epre = epi.pre(wr, wc, fr, fq); epi.land(epre);
    if (has_next) { int tn = threadIdx.x; asm volatile("" : "+v"(tn)); STAGE_T1(tn, nxt); }
    epi(acc, wr, wc, fr, fq, NCT - 1, epre);
#undef SA
#undef SB
#undef STAGE_A
#undef STAGE_B
#undef STAGE_FIRST2
#undef STAGE_T0
#undef STAGE_T1
#undef LDA
#undef LDB
#undef MMA
}
}

namespace att {
using bf16 = __hip_bfloat16;
constexpr int DH = 128, NW = 8, QBLK = 32, KVBLK = 64;
constexpr float SCALE = 0.125f;
constexpr float THR = 8.f;
constexpr int SDEPTH = 2;
constexpr size_t SHM_V = KVBLK * DH * 2, SHM_K = KVBLK * DH * 2, SHM_ATTN = 2 * SHM_V + 2 * SHM_K + NW * 64 * 4;
#define KSWZ(row, colB) ((row) * 256 + ((colB) ^ (((row) & 7) << 4)))
#define SBAR() __builtin_amdgcn_sched_barrier(0)
__device__ __forceinline__ int crow(int r, int hi) { return (r & 3) + 8 * (r >> 2) + 4 * hi; }
__device__ __forceinline__ void partialSM(f32x16& p0, f32x16& p1, float& m_reg, float& mn, float& alpha) {
  constexpr float C = SCALE * 1.4426950408889634f;
  float pmax = p0[0]; for (int r = 1; r < 16; ++r) pmax = fmaxf(pmax, p0[r]); for (int r = 0; r < 16; ++r) pmax = fmaxf(pmax, p1[r]);
  { auto rr = __builtin_amdgcn_permlane32_swap(__float_as_uint(pmax), __float_as_uint(pmax), false, false);
    pmax = fmaxf(__uint_as_float(rr[0]), __uint_as_float(rr[1])); }
  if (__builtin_expect(__all(pmax - m_reg <= THR / SCALE), 1)) { mn = m_reg; alpha = 1.f; }
  else { mn = fmaxf(m_reg, pmax); alpha = __builtin_amdgcn_exp2f((m_reg - mn) * C); m_reg = mn; }
  float mnC = -mn * C;
  for (int r = 0; r < 16; ++r) p0[r] = fmaf(p0[r], C, mnC); for (int r = 0; r < 16; ++r) p1[r] = fmaf(p1[r], C, mnC);
  for (int r = 0; r < 16; ++r) p0[r] = __builtin_amdgcn_exp2f(p0[r]);
}
__device__ __forceinline__ void finishSM(f32x16& p0, f32x16& p1, float alpha, float& l_reg, bf16x8& pa0, bf16x8& pa1, bf16x8& pa2, bf16x8& pa3) {
  for (int r = 0; r < 16; ++r) p1[r] = __builtin_amdgcn_exp2f(p1[r]);
  float ps = 0; for (int r = 0; r < 16; ++r) ps += p0[r]; for (int r = 0; r < 16; ++r) ps += p1[r];
  { auto rr = __builtin_amdgcn_permlane32_swap(__float_as_uint(ps), __float_as_uint(ps), false, false);
    ps = __uint_as_float(rr[0]) + __uint_as_float(rr[1]); }
  l_reg = l_reg * alpha + ps;
#define PK4(P, BASE, OUT) do { unsigned a0 = cvtpk(P[BASE + 0], P[BASE + 1]), a1 = cvtpk(P[BASE + 2], P[BASE + 3]);   \
    unsigned b0 = cvtpk(P[BASE + 4], P[BASE + 5]), b1 = cvtpk(P[BASE + 6], P[BASE + 7]);                              \
    auto r0 = __builtin_amdgcn_permlane32_swap(a0, b0, false, false); auto r1 = __builtin_amdgcn_permlane32_swap(a1, b1, false, false); \
    u32x4 w = {r0[0], r1[0], r0[1], r1[1]}; OUT = *reinterpret_cast<bf16x8*>(&w); } while (0)
  PK4(p0, 0, pa0); PK4(p0, 8, pa1); PK4(p1, 0, pa2); PK4(p1, 8, pa3);
#undef PK4
}
__device__ __forceinline__ void qkt(f32x16& p0, f32x16& p1, const bf16* Ks, const bf16x8* qr, int r32, int hi) {
  p0 = f32x16{}; p1 = f32x16{};
  for (int d0 = 0; d0 < 8; ++d0) { int cb = (d0 * 16 + hi * 8) * 2;
    bf16x8 b0 = *reinterpret_cast<const bf16x8*>((const char*)Ks + KSWZ(r32, cb));
    bf16x8 b1 = *reinterpret_cast<const bf16x8*>((const char*)Ks + KSWZ(32 + r32, cb));
    p0 = __builtin_amdgcn_mfma_f32_32x32x16_bf16(b0, qr[d0], p0, 0, 0, 0);
    p1 = __builtin_amdgcn_mfma_f32_32x32x16_bf16(b1, qr[d0], p1, 0, 0, 0); }
}
__device__ __forceinline__ int v_st(int k, int c) { const int kk = (k & ~0xC) | ((k & 4) << 1) | ((k & 8) >> 1); return ((kk >> 3) * 4 + (c >> 5)) * 512 + ((kk & 7) * 32 + (c & 31)) * 2; }
__device__ __forceinline__ int v_rd_base(int lane) { return ((lane & 3) << 3) | (((lane >> 2) & 3) << 6) | (((lane >> 4) & 1) << 5) | (((lane >> 5) & 1) << 8); }
constexpr int v_rd_off(int d0, int ks, int half) { return d0 * 512 + ks * 4096 + half * 2048; }
template <int OFF> __device__ __forceinline__ s16x4 tr_read(int vb) {
  s16x4 r; asm volatile("ds_read_b64_tr_b16 %0, %1 offset:%2" : "=&v"(r) : "v"(vb), "i"(OFF) : "memory"); return r;
}
template <int D0> __device__ __forceinline__ void pv_one(f32x16& od, int vb, bf16x8 pa0, bf16x8 pa1, bf16x8 pa2, bf16x8 pa3) {
  const s16x4 l0 = tr_read<v_rd_off(D0, 0, 0)>(vb), h0 = tr_read<v_rd_off(D0, 0, 1)>(vb), l1 = tr_read<v_rd_off(D0, 1, 0)>(vb), h1 = tr_read<v_rd_off(D0, 1, 1)>(vb);
  const s16x4 l2 = tr_read<v_rd_off(D0, 2, 0)>(vb), h2 = tr_read<v_rd_off(D0, 2, 1)>(vb), l3 = tr_read<v_rd_off(D0, 3, 0)>(vb), h3 = tr_read<v_rd_off(D0, 3, 1)>(vb);
  asm volatile("s_waitcnt lgkmcnt(0)" ::: "memory"); SBAR();
#define PK(L, H) (bf16x8){L[0], L[1], L[2], L[3], H[0], H[1], H[2], H[3]}
  od = __builtin_amdgcn_mfma_f32_32x32x16_bf16(pa0, PK(l0, h0), od, 0, 0, 0);
  od = __builtin_amdgcn_mfma_f32_32x32x16_bf16(pa1, PK(l1, h1), od, 0, 0, 0);
  od = __builtin_amdgcn_mfma_f32_32x32x16_bf16(pa2, PK(l2, h2), od, 0, 0, 0);
  od = __builtin_amdgcn_mfma_f32_32x32x16_bf16(pa3, PK(l3, h3), od, 0, 0, 0);
#undef PK
}
__device__ __forceinline__ void pv_d0(f32x16* o, int vb, bf16x8 pa0, bf16x8 pa1, bf16x8 pa2, bf16x8 pa3) {
  pv_one<0>(o[0], vb, pa0, pa1, pa2, pa3); pv_one<1>(o[1], vb, pa0, pa1, pa2, pa3); pv_one<2>(o[2], vb, pa0, pa1, pa2, pa3); pv_one<3>(o[3], vb, pa0, pa1, pa2, pa3);
}
template <int LDQ, int LDK, int LDV, int LDO>
__device__ __forceinline__ void attn_dense_body(const bf16* __restrict__ Qb, const bf16* __restrict__ Kh, const bf16* __restrict__ Vh,
                                                float* __restrict__ Ob, int seq, char* lds) {
  int tid = threadIdx.x; asm volatile("" : "+v"(tid));
  const int wid = tid >> 6, lane = tid & 63, r32 = lane & 31, hi = lane >> 5;
  bf16* V_lds = (bf16*)lds; bf16* K_lds = (bf16*)(lds + 2 * SHM_V);
  float* ws = (float*)(lds + 2 * SHM_V + 2 * SHM_K) + wid * 64; float* li_l = ws; float* al_l = ws + 32;
  float m_reg = -1e30f, l_reg = 0; f32x16 o[4] = {}; bf16x8 qr[8];
  const bf16* Qw = Qb + (long)(wid * QBLK + r32) * LDQ + hi * 8;
#pragma unroll
  for (int d0 = 0; d0 < 8; ++d0) qr[d0] = *reinterpret_cast<const bf16x8*>(Qw + d0 * 16);
  const int sr = tid >> 4, sc = (tid & 15) * 8, vst0 = v_st(sr, sc), vst1 = v_st(32 + sr, sc);
  const int vb0 = (int)(uintptr_t)V_lds + v_rd_base(lane);
  const bf16* Vw = Vh + sr * LDV + sc; const bf16* Kw = Kh + sr * LDK + sc;
  struct { bf16x8 vs0, vs1, ks0, ks1; } sr_[SDEPTH];
#define SLOAD(i, k0) do { sr_[i].vs0 = *reinterpret_cast<const bf16x8*>(Vw + (k0) * LDV); sr_[i].vs1 = *reinterpret_cast<const bf16x8*>(Vw + ((k0) + 32) * LDV); \
    sr_[i].ks0 = *reinterpret_cast<const bf16x8*>(Kw + (k0) * LDK); sr_[i].ks1 = *reinterpret_cast<const bf16x8*>(Kw + ((k0) + 32) * LDK); } while (0)
#define SWRITE(b, i) do { *(bf16x8*)((char*)V_lds + (b) * SHM_V + vst0) = sr_[i].vs0;          \
    *(bf16x8*)((char*)V_lds + (b) * SHM_V + vst1) = sr_[i].vs1; int kc = sc * 2;               \
    *(bf16x8*)((char*)K_lds + (b) * SHM_K + KSWZ(sr, kc)) = sr_[i].ks0;                       \
    *(bf16x8*)((char*)K_lds + (b) * SHM_K + KSWZ(32 + sr, kc)) = sr_[i].ks1; } while (0)
#define SWAIT() do { asm volatile("s_waitcnt vmcnt(4)" ::: "memory"); } while (0)
#define RESC(a) do { if (__any((a) < 1.f)) { if (hi == 0) al_l[r32] = (a); asm volatile("s_waitcnt lgkmcnt(0)" ::: "memory"); \
    for (int d = 0; d < 4; ++d) for (int r = 0; r < 16; ++r) o[d][r] *= al_l[crow(r, hi)]; } } while (0)
  f32x16 pA0, pA1, pB0, pB1; float mnA, mnB, alA, alB; bf16x8 pa0, pa1, pa2, pa3; const int NT = seq / KVBLK;
  constexpr int SE = 0, SO = SDEPTH - 1;
  SLOAD(SE, 0); asm volatile("s_waitcnt vmcnt(0)" ::: "memory"); SWRITE(0, SE); __syncthreads();
  qkt(pA0, pA1, K_lds, qr, r32, hi); partialSM(pA0, pA1, m_reg, mnA, alA);
  SLOAD(SO, KVBLK); if (2 < NT) SLOAD(SE, 2 * KVBLK);
  SWAIT(); SWRITE(1, SO); __syncthreads();
  for (int j = 1; j + 1 < NT; j += 2) {
    SBAR(); qkt(pB0, pB1, (bf16*)((char*)K_lds + SHM_K), qr, r32, hi);
    finishSM(pA0, pA1, alA, l_reg, pa0, pa1, pa2, pa3); SBAR();
    SLOAD(SO, (j + SDEPTH) * KVBLK); SBAR();
    pv_d0(o, vb0, pa0, pa1, pa2, pa3); partialSM(pB0, pB1, m_reg, mnB, alB);
    __syncthreads(); SWAIT(); SWRITE(0, SE);
    RESC(alB); __syncthreads();
    SBAR(); qkt(pA0, pA1, K_lds, qr, r32, hi);
    finishSM(pB0, pB1, alB, l_reg, pa0, pa1, pa2, pa3); SBAR();
    if (j + 3 < NT) SLOAD(SE, (j + 1 + SDEPTH) * KVBLK); SBAR();
    pv_d0(o, vb0 + (int)SHM_V, pa0, pa1, pa2, pa3); partialSM(pA0, pA1, m_reg, mnA, alA);
    __syncthreads(); SWAIT(); SWRITE(1, SO);
    RESC(alA); __syncthreads();
  }
  SBAR(); qkt(pB0, pB1, (bf16*)((char*)K_lds + SHM_K), qr, r32, hi);
  finishSM(pA0, pA1, alA, l_reg, pa0, pa1, pa2, pa3); SBAR();
  pv_d0(o, vb0, pa0, pa1, pa2, pa3); partialSM(pB0, pB1, m_reg, mnB, alB);
  __syncthreads(); RESC(alB);
  finishSM(pB0, pB1, alB, l_reg, pa0, pa1, pa2, pa3); SBAR();
  pv_d0(o, vb0 + (int)SHM_V, pa0, pa1, pa2, pa3);
  if (hi == 0) li_l[r32] = l_reg; asm volatile("s_waitcnt lgkmcnt(0)" ::: "memory");
  float rli[16];
#pragma unroll
  for (int r = 0; r < 16; ++r) rli[r] = __builtin_amdgcn_rcpf(li_l[crow(r, hi)]);
  float* Ow = Ob + (long)(wid * QBLK) * LDO;
#pragma unroll
  for (int r = 0; r < 16; ++r) { int orow = crow(r, hi);
    for (int d0 = 0; d0 < 4; ++d0) Ow[(long)orow * LDO + d0 * 32 + r32] = o[d0][r] * rli[r]; }
#undef SLOAD
#undef SWRITE
#undef SWAIT
#undef RESC
}
constexpr size_t SHM_K64 = KVBLK * 64 * 2, SHM_ATTN64 = 2 * SHM_V + 2 * SHM_K64 + NW * 64 * 4;
#define KSWZ64(row, colB) ((row) * 128 + ((colB) ^ ((((row) >> 1) & 7) << 4)))
__device__ __forceinline__ void qkt64(f32x16& p0, f32x16& p1, const bf16* Ks, const bf16x8* qr, int r32, int hi) {
  p0 = f32x16{}; p1 = f32x16{};
  for (int d0 = 0; d0 < 4; ++d0) { int cb = (d0 * 16 + hi * 8) * 2;
    bf16x8 b0 = *reinterpret_cast<const bf16x8*>((const char*)Ks + KSWZ64(r32, cb));
    bf16x8 b1 = *reinterpret_cast<const bf16x8*>((const char*)Ks + KSWZ64(32 + r32, cb));
    p0 = __builtin_amdgcn_mfma_f32_32x32x16_bf16(b0, qr[d0], p0, 0, 0, 0);
    p1 = __builtin_amdgcn_mfma_f32_32x32x16_bf16(b1, qr[d0], p1, 0, 0, 0); }
}
template <int LDQ, int LDK, int LDV, int LDO>
__device__ __forceinline__ void attn_body64(const bf16* __restrict__ Qb, const bf16* __restrict__ Kh, const bf16* __restrict__ Vh,
                                                float* __restrict__ Ob, int seq, char* lds) {
  int tid = threadIdx.x; asm volatile("" : "+v"(tid));
  const int wid = tid >> 6, lane = tid & 63, r32 = lane & 31, hi = lane >> 5;
  bf16* V_lds = (bf16*)lds; bf16* K_lds = (bf16*)(lds + 2 * SHM_V);
  float* ws = (float*)(lds + 2 * SHM_V + 2 * SHM_K64) + wid * 64; float* li_l = ws; float* al_l = ws + 32;
  float m_reg = -1e30f, l_reg = 0; f32x16 o[4] = {}; bf16x8 qr[4];
  const bf16* Qw = Qb + (long)(wid * QBLK + r32) * LDQ + hi * 8;
#pragma unroll
  for (int d0 = 0; d0 < 4; ++d0) qr[d0] = *reinterpret_cast<const bf16x8*>(Qw + d0 * 16);
  const int sr = tid >> 4, sc = (tid & 15) * 8, vst0 = v_st(sr, sc), vst1 = v_st(32 + sr, sc);
  const int vb0 = (int)(uintptr_t)V_lds + v_rd_base(lane);
  const int kr = tid >> 3, kc = (tid & 7) * 8;
  const bf16* Vw = Vh + sr * LDV + sc; const bf16* Kw = Kh + kr * LDK + kc;
  struct { bf16x8 vs0, vs1, ks0; } sr_[SDEPTH];
#define SLOAD(i, k0) do { sr_[i].vs0 = *reinterpret_cast<const bf16x8*>(Vw + (k0) * LDV); sr_[i].vs1 = *reinterpret_cast<const bf16x8*>(Vw + ((k0) + 32) * LDV); \
    sr_[i].ks0 = *reinterpret_cast<const bf16x8*>(Kw + (k0) * LDK); } while (0)
#define SWRITE(b, i) do { *(bf16x8*)((char*)V_lds + (b) * SHM_V + vst0) = sr_[i].vs0;          \
    *(bf16x8*)((char*)V_lds + (b) * SHM_V + vst1) = sr_[i].vs1;               \
    *(bf16x8*)((char*)K_lds + (b) * SHM_K64 + KSWZ64(kr, kc * 2)) = sr_[i].ks0; } while (0)
#define SWAIT() do { asm volatile("s_waitcnt vmcnt(3)" ::: "memory"); } while (0)
#define RESC(a) do { if (__any((a) < 1.f)) { if (hi == 0) al_l[r32] = (a); asm volatile("s_waitcnt lgkmcnt(0)" ::: "memory"); \
    for (int d = 0; d < 4; ++d) for (int r = 0; r < 16; ++r) o[d][r] *= al_l[crow(r, hi)]; } } while (0)
  f32x16 pA0, pA1, pB0, pB1; float mnA, mnB, alA, alB; bf16x8 pa0, pa1, pa2, pa3; const int NT = seq / KVBLK;
  constexpr int SE = 0, SO = SDEPTH - 1;
  SLOAD(SE, 0); asm volatile("s_waitcnt vmcnt(0)" ::: "memory"); SWRITE(0, SE); __syncthreads();
  qkt64(pA0, pA1, K_lds, qr, r32, hi); partialSM(pA0, pA1, m_reg, mnA, alA);
  SLOAD(SO, KVBLK); if (2 < NT) SLOAD(SE, 2 * KVBLK);
  SWAIT(); SWRITE(1, SO); __syncthreads();
  for (int j = 1; j + 1 < NT; j += 2) {
    SBAR(); qkt64(pB0, pB1, (bf16*)((char*)K_lds + SHM_K64), qr, r32, hi);
    finishSM(pA0, pA1, alA, l_reg, pa0, pa1, pa2, pa3); SBAR();
    SLOAD(SO, (j + SDEPTH) * KVBLK); SBAR();
    pv_d0(o, vb0, pa0, pa1, pa2, pa3); partialSM(pB0, pB1, m_reg, mnB, alB);
    __syncthreads(); SWAIT(); SWRITE(0, SE);
    RESC(alB); __syncthreads();
    SBAR(); qkt64(pA0, pA1, K_lds, qr, r32, hi);
    finishSM(pB0, pB1, alB, l_reg, pa0, pa1, pa2, pa3); SBAR();
    if (j + 3 < NT) SLOAD(SE, (j + 1 + SDEPTH) * KVBLK); SBAR();
    pv_d0(o, vb0 + (int)SHM_V, pa0, pa1, pa2, pa3); partialSM(pA0, pA1, m_reg, mnA, alA);
    __syncthreads(); SWAIT(); SWRITE(1, SO);
    RESC(alA); __syncthreads();
  }
  SBAR(); qkt64(pB0, pB1, (bf16*)((char*)K_lds + SHM_K64), qr, r32, hi);
  finishSM(pA0, pA1, alA, l_reg, pa0, pa1, pa2, pa3); SBAR();
  pv_d0(o, vb0, pa0, pa1, pa2, pa3); partialSM(pB0, pB1, m_reg, mnB, alB);
  __syncthreads(); RESC(alB);
  finishSM(pB0, pB1, alB, l_reg, pa0, pa1, pa2, pa3); SBAR();
  pv_d0(o, vb0 + (int)SHM_V, pa0, pa1, pa2, pa3);
  if (hi == 0) li_l[r32] = l_reg; asm volatile("s_waitcnt lgkmcnt(0)" ::: "memory");
  float rli[16];
#pragma unroll
  for (int r = 0; r < 16; ++r) rli[r] = __builtin_amdgcn_rcpf(li_l[crow(r, hi)]);
  float* Ow = Ob + (long)(wid * QBLK) * LDO;
#pragma unroll
  for (int r = 0; r < 16; ++r) { int orow = crow(r, hi);
    for (int d0 = 0; d0 < 4; ++d0) Ow[(long)orow * LDO + d0 * 32 + r32] = o[d0][r] * rli[r]; }
#undef SLOAD
#undef SWRITE
#undef SWAIT
#undef RESC
}
}

__device__ __forceinline__ float silu_acc(float x) { return x / (1.f + expf(-x)); }

__device__ __forceinline__ void p0_modv(const Frame& F, const Args& a, int u) {
    const int l = u / 96, c0 = (u % 96) * 64, tid = F.tid;
    float* sc = (float*)F.lds;
    for (int i = tid; i < 9 * 1024; i += NTHR) { const int r = i >> 10, k = i & 1023; const float v = r < 8 ? a.in[I_C][r * 1024 + k] : a.in[I_CCTX][k]; sc[i] = silu_acc(v); }
    __syncthreads();
    const int col = tid & 63, kp = tid >> 6;
    float acc[9];
#pragma unroll
    for (int r = 0; r < 9; ++r) acc[r] = 0.f;
    const float* wm = a.in[I_WMOD] + (size_t)l * 1024 * 6144 + c0 + col;
    for (int k0 = kp * 128; k0 < kp * 128 + 128; k0 += 32) { float w[32];
#pragma unroll
        for (int i = 0; i < 32; ++i) w[i] = wm[(size_t)(k0 + i) * 6144];
#pragma unroll
        for (int i = 0; i < 32; ++i) {
#pragma unroll
            for (int r = 0; r < 9; ++r) acc[r] = fmaf(sc[r * 1024 + k0 + i], w[i], acc[r]); } }
    float* red = sc + 9 * 1024;
#pragma unroll
    for (int r = 0; r < 9; ++r) red[(kp * 9 + r) * 64 + col] = acc[r];
    __syncthreads();
    float* modv = wsp<float>(F, WS_MODV);
    for (int i = tid; i < 576; i += NTHR) { const int r = i >> 6, cc = i & 63; float s = 0.f;
        for (int q = 0; q < 8; ++q) s += red[(q * 9 + r) * 64 + cc];
        modv[((size_t)l * 9 + r) * 6144 + c0 + cc] = s + a.in[I_BMOD][l * 6144 + c0 + cc]; }
    __syncthreads();
}

__device__ __forceinline__ float hy_hidden(const Args& a, int l, int L, int t, int lane) {
    const float t01 = (float)t / (float)(L - 1);
    const float wpos = (float)(6.283185307179586 / L) * (float)t;
    const float* w1 = a.in[I_HYW1] + l * 17 * 64; const float* b1 = a.in[I_HYB1] + l * 64;
    const float* w2 = a.in[I_HYW2] + l * 64 * 64; const float* b2 = a.in[I_HYB2] + l * 64;
    const float* fq = a.in[I_HYFREQ] + l * 128;
    float av = fmaf(t01, w1[lane], b1[lane]);
#pragma unroll
    for (int j = 0; j < 8; ++j) { const float band = 1e-4f + (float)j * ((7.f - 1e-4f) / 7.f); const float ang = wpos * band;
        av = fmaf(cosf(ang), w1[(1 + j) * 64 + lane], av); av = fmaf(-sinf(ang), w1[(9 + j) * 64 + lane], av); }
    const float h1 = sinf(fq[lane] * av);
    float a2 = b2[lane];
    for (int j = 0; j < 64; ++j) a2 = fmaf(shi(h1, j), w2[j * 64 + lane], a2);
    return sinf(fq[64 + lane] * a2);
}
template <int NP>
__device__ __forceinline__ void hy_hiddenN(const Args& a, int l, int L, int t0, int ts, int lane, float (&out)[NP]) {
    const float* w1 = a.in[I_HYW1] + l * 17 * 64; const float* b1 = a.in[I_HYB1] + l * 64;
    const float* w2 = a.in[I_HYW2] + l * 64 * 64; const float* b2 = a.in[I_HYB2] + l * 64;
    const float* fq = a.in[I_HYFREQ] + l * 128;
    const int pi = lane >> 3, pj = lane & 7;
    const float band = 1e-4f + (float)pj * ((7.f - 1e-4f) / 7.f);
    const float ang = ((float)(6.283185307179586 / L) * (float)(t0 + ts * pi)) * band;
    const float cv = cosf(ang), sv = -sinf(ang);
    float w1r[17];
#pragma unroll
    for (int j = 0; j < 17; ++j) w1r[j] = w1[j * 64 + lane];
    const float b1v = b1[lane], b2v = b2[lane], f0 = fq[lane], f1 = fq[64 + lane];
    float h1[NP];
#pragma unroll
    for (int i = 0; i < NP; ++i) { const float t01 = (float)(t0 + ts * i) / (float)(L - 1);
        float av = fmaf(t01, w1r[0], b1v);
#pragma unroll
        for (int j = 0; j < 8; ++j) { av = fmaf(shi(cv, i * 8 + j), w1r[1 + j], av); av = fmaf(shi(sv, i * 8 + j), w1r[9 + j], av); }
        h1[i] = sinf(f0 * av); }
    float a2[NP];
#pragma unroll
    for (int i = 0; i < NP; ++i) a2[i] = b2v;
#pragma unroll 1
    for (int jb = 0; jb < 64; jb += 16) { float w2r[16];
#pragma unroll
        for (int j = 0; j < 16; ++j) w2r[j] = w2[(jb + j) * 64 + lane];
#pragma unroll
        for (int j = 0; j < 16; ++j) {
#pragma unroll
            for (int i = 0; i < NP; ++i) a2[i] = fmaf(shi(h1[i], jb + j), w2r[j], a2[i]); } }
#pragma unroll
    for (int i = 0; i < NP; ++i) out[i] = sinf(f1 * a2[i]);
}
__device__ __forceinline__ void p0_hytab(const Frame& F, const Args& a, int u) {
    const int l = 0, rr = 2048 + u * 8 + F.wave, lane = F.lane;
    const int L = rr < 2048 ? 2048 : 256, t = rr < 2048 ? rr : rr - 2048;
    wsp<float>(F, WS_HYT)[((size_t)l * 2304 + rr) * 64 + lane] = hy_hidden(a, l, L, t, lane);
}
__device__ __forceinline__ size_t kf_off(int c, int idx) { return ((size_t)(idx >> 6) * 256 + c) * 64 + (idx & 63); }
__device__ __forceinline__ void p0_hyfilt(const Frame& F, const Args& a, int u) {
    constexpr int L = SEQ;
    const int l = u >> 7, tb = (u >> 1) & 63, o = u & 1;
    float* h2s = (float*)F.lds;
    float* tile = h2s + 32 * 64;
    const int tid = F.tid, lane = F.lane, wave = F.wave;
    { float hv[4]; hy_hiddenN<4>(a, l, L, tb * 32 + wave, 8, lane, hv);
#pragma unroll
      for (int i = 0; i < 4; ++i) h2s[(wave + 8 * i) * 64 + lane] = hv[i]; }
    __syncthreads();
    const int c4 = (tid & 127) * 4, tg = tid >> 7;
    const float* w3 = a.in[I_HYW3] + (size_t)l * 64 * 1024 + o * 512 + c4;
    f32x4 acc[8];
#pragma unroll
    for (int r = 0; r < 8; ++r) acc[r] = (f32x4){0.f, 0.f, 0.f, 0.f};
#pragma unroll 1
    for (int ib = 0; ib < 64; ib += 8) { f32x4 wv[8];
#pragma unroll
        for (int k = 0; k < 8; ++k) wv[k] = *(const f32x4*)(w3 + (size_t)(ib + k) * 1024);
#pragma unroll
        for (int r = 0; r < 8; ++r) { const f32x4 h0 = *(const f32x4*)(h2s + (tg * 8 + r) * 64 + ib), h1 = *(const f32x4*)(h2s + (tg * 8 + r) * 64 + ib + 4);
            acc[r] += h0[0] * wv[0] + h0[1] * wv[1] + h0[2] * wv[2] + h0[3] * wv[3] + h1[0] * wv[4] + h1[1] * wv[5] + h1[2] * wv[6] + h1[3] * wv[7]; } }
    const float la = -3.0701134573253945f, lb = -15.350567286626973f;
#pragma unroll
    for (int q = 0; q < 4; ++q) { const int col = c4 + q; const float delta = fabsf(la + (float)(col & 255) * ((lb - la) / 255.f));
#pragma unroll
        for (int r = 0; r < 8; ++r) { const int t = tb * 32 + tg * 8 + r; tile[col * 33 + tg * 8 + r] = acc[r][q] * (expf(-((float)t / (float)(L - 1)) * delta) + 0.05f); } }
    __syncthreads();
    float* KF = wsp<float>(F, WS_KF) + ((size_t)(l * 2 + o) * 256) * 4096;
    for (int cc = wave * 2 + (lane >> 5); cc < 512; cc += 16) { const int dir = cc >> 8, c = cc & 255, tl = lane & 31, t = tb * 32 + tl;
        const int idx = dir == 0 ? L + t : (t == 0 ? 0 : L - t);
        KF[kf_off(c, idx)] = tile[cc * 33 + tl]; }
    __syncthreads();
}

__device__ __forceinline__ void p0_wg(const Frame& F, const Args& a, int l) {
    float* wg = wsp<float>(F, WS_WG) + l * 16 * 1024;
    const float* w = a.in[I_WIN] + (size_t)l * 1024 * INC + 1024;
    for (int i = F.tid; i < 16 * 1024; i += NTHR) { const int g = i & 15, k = i >> 4; wg[g * 1024 + k] = w[(size_t)k * INC + g]; }
}

__device__ __forceinline__ void transpose_tile(const Frame& F, const float* __restrict__ src, int lds_, int k0, int n0, bf16_t* __restrict__ dst, int ldd) {
    float* tile = (float*)F.lds;
    const int tid = F.tid, r = tid >> 4, c4 = (tid & 15) * 4;
#pragma unroll
    for (int i = 0; i < 2; ++i) { const f32x4 v = *(const f32x4*)(src + (size_t)(k0 + r + 32 * i) * lds_ + n0 + c4);
        float* tp = tile + (r + 32 * i) * 65 + c4; tp[0] = v[0]; tp[1] = v[1]; tp[2] = v[2]; tp[3] = v[3]; }
    __syncthreads();
    const int n = tid >> 3, ks = (tid & 7) * 8;
    float x[8];
#pragma unroll
    for (int j = 0; j < 8; ++j) x[j] = tile[(ks + j) * 65 + n];
    u32x4 w = {cvtpk(x[0], x[1]), cvtpk(x[2], x[3]), cvtpk(x[4], x[5]), cvtpk(x[6], x[7])};
    *(u32x4*)(dst + (size_t)n * ldd + k0 + ks) = w;
    __syncthreads();
}

template <class DRow>
__device__ __forceinline__ void transpose_wide(const Frame& F, const float* __restrict__ src, int lds_, int k0, int n0, bf16_t* __restrict__ dst, int ldd, DRow drow) {
    constexpr int KR = 128;
    float* tile = (float*)F.lds;
    int tid = threadIdx.x; asm volatile("" : "+v"(tid)); const int r = tid >> 6, c4 = (tid & 63) * 4;
    f32x4 v[KR / 8];
#pragma unroll
    for (int i = 0; i < KR / 8; ++i) v[i] = *(const f32x4*)(src + (size_t)(k0 + r + 8 * i) * lds_ + n0 + c4);
#pragma unroll
    for (int i = 0; i < KR / 8; ++i) { float* tp = tile + (r + 8 * i) * 261 + c4; tp[0] = v[i][0]; tp[1] = v[i][1]; tp[2] = v[i][2]; tp[3] = v[i][3]; }
    __syncthreads();
#pragma unroll
    for (int p = 0; p < KR / 16; ++p) { const int idx = tid + NTHR * p; const int n = (idx >> 4) & 255, ks = (idx & 15) * 8;
        float x[8];
#pragma unroll
        for (int j = 0; j < 8; ++j) x[j] = tile[(ks + j) * 261 + n];
        u32x4 w = {cvtpk(x[0], x[1]), cvtpk(x[2], x[3]), cvtpk(x[4], x[5]), cvtpk(x[6], x[7])};
        *(u32x4*)(dst + (size_t)drow(n) * ldd + k0 + ks) = w; }
    __syncthreads();
}
constexpr int TR_PER_LAYER = 832 + 256 + 192 + NE * 192;
__device__ __forceinline__ void p0_transpose(const Frame& F, const Args& a, int q) {
    const int l = q / TR_PER_LAYER; int r = q % TR_PER_LAYER;
    if (r < 832) { const int nt = r / 16, kt = r % 16; const int n0s = nt * 64 < 1024 ? nt * 64 : nt * 64 + 16;
        transpose_tile(F, a.in[I_WIN] + (size_t)l * 1024 * INC, INC, kt * 64, n0s, wsp<bf16_t>(F, WS_WIN) + ((size_t)l * NU + nt * 64) * 1024, 1024); return; }
    r -= 832;
    if (r < 256) { const int nt = r / 16, kt = r % 16;
        transpose_tile(F, a.in[I_WOUT] + (size_t)l * 1024 * 1024, 1024, kt * 64, nt * 64, wsp<bf16_t>(F, WS_WOUT) + ((size_t)l * 1024 + nt * 64) * 1024, 1024); return; }
    r -= 256;
    if (r < 128) { const int which = r / 64, rr = r % 64, nt = rr / 16, kt = rr % 16; const int drow = 256 * ((nt * 64) / 128) + (nt * 64) % 128 + which * 128;
        transpose_tile(F, a.in[which ? I_SW3 : I_SW1] + (size_t)l * 1024 * 256, 256, kt * 64, nt * 64, wsp<bf16_t>(F, WS_WSH13) + ((size_t)l * 512 + drow) * 1024, 1024); return; }
    r -= 128;
    if (r < 64) { const int nt = r / 4, kt = r % 4;
        transpose_tile(F, a.in[I_SW2] + (size_t)l * 256 * 1024, 1024, kt * 64, nt * 64, wsp<bf16_t>(F, WS_WSH2) + ((size_t)l * 1024 + nt * 64) * 256, 256); return; }
    r -= 64;
    const int e = r / 192, x = r % 192;
    if (x < 128) { const int which = x / 64, rr = x % 64, nt = rr / 16, kt = rr % 16; const int drow = 256 * ((nt * 64) / 128) + (nt * 64) % 128 + which * 128;
        transpose_tile(F, a.in[which ? I_EW3 : I_EW1] + ((size_t)l * NE + e) * 1024 * 256, 256, kt * 64, nt * 64, wsp<bf16_t>(F, WS_WE13) + (((size_t)l * NE + e) * 512 + drow) * 1024, 1024); return; }
    { const int rr = x - 128, nt = rr / 4, kt = rr % 4;
        transpose_tile(F, a.in[I_EW2] + ((size_t)l * NE + e) * 256 * 1024, 1024, kt * 64, nt * 64, wsp<bf16_t>(F, WS_WE2) + (((size_t)l * NE + e) * 1024 + nt * 64) * 256, 256); }
}

template <int NT, class DRow>
__device__ __forceinline__ void transpose_stream(const Frame& F, const float* __restrict__ src, int lds_, int k0, int n0, bf16_t* __restrict__ dst, int ldd, DRow drow) {
    float* tile = (float*)F.lds;
    int tid = threadIdx.x; asm volatile("" : "+v"(tid)); const int r = tid >> 6, c4 = (tid & 63) * 4;
    f32x4 v[8];
#pragma unroll
    for (int i = 0; i < 8; ++i) v[i] = __builtin_nontemporal_load((const f32x4*)(src + (size_t)(k0 + r + 8 * i) * lds_ + n0 + c4));
#pragma unroll 1
    for (int t = 0; t < NT; ++t) { float* tl = tile + (t & 1) * (64 * 261);
#pragma unroll
        for (int i = 0; i < 8; ++i) { float* tp = tl + (r + 8 * i) * 261 + c4; tp[0] = v[i][0]; tp[1] = v[i][1]; tp[2] = v[i][2]; tp[3] = v[i][3]; }
        if (t + 1 < NT) {
#pragma unroll
            for (int i = 0; i < 8; ++i) v[i] = __builtin_nontemporal_load((const f32x4*)(src + (size_t)(k0 + 64 * (t + 1) + r + 8 * i) * lds_ + n0 + c4)); }
        __syncthreads();
#pragma unroll
        for (int p = 0; p < 4; ++p) { const int idx = tid + NTHR * p; const int n = idx >> 3, ks = (idx & 7) * 8;
            float x[8];
#pragma unroll
            for (int j = 0; j < 8; ++j) x[j] = tl[(ks + j) * 261 + n];
            u32x4 w = {cvtpk(x[0], x[1]), cvtpk(x[2], x[3]), cvtpk(x[4], x[5]), cvtpk(x[6], x[7])};
            __builtin_nontemporal_store(w, (u32x4*)(dst + (size_t)drow(n) * ldd + k0 + 64 * t + ks)); }
    }
    __syncthreads();
}
__device__ __forceinline__ void expert_cvt_job(const Frame& F, int l, int q) {
    const int e = q / 6, x = q % 6;
    if (x < 4) { const int which = x >> 1, kh = x & 1;
        transpose_stream<8>(F, (which ? F.ew3 : F.ew1) + ((size_t)l * NE + e) * 1024 * 256, 256, kh * 512, 0, wsp<bf16_t>(F, WS_WE13) + ((size_t)l * NE + e) * 512 * 1024, 1024,
                            [which](int n) { return 256 * (n >> 7) + (n & 127) + 128 * which; }); }
    else { const int nh = x & 1;
        for (int nt = 0; nt < 2; ++nt)
            transpose_stream<4>(F, F.ew2 + ((size_t)l * NE + e) * 256 * 1024, 1024, 0, nh * 512 + nt * 256, wsp<bf16_t>(F, WS_WE2) + (((size_t)l * NE + e) * 1024 + nh * 512 + nt * 256) * 256, 256,
                                [](int n) { return n; }); }
}
__device__ __forceinline__ void p0_transpose_job(const Frame& F, const Args& a, int q) {
    const int l = q / 42; int r = q % 42;
    if (r < 26) { const int nt = r >> 1, kh = r & 1; const int n0s = nt * 256 < 1024 ? nt * 256 : nt * 256 + 16;
        transpose_stream<8>(F, a.in[I_WIN] + (size_t)l * 1024 * INC, INC, kh * 512, n0s, wsp<bf16_t>(F, WS_WIN) + ((size_t)l * NU + nt * 256) * 1024, 1024, [](int n) { return n; }); return; }
    r -= 26;
    if (r < 8) { const int nt = r >> 1, kh = r & 1;
        transpose_stream<8>(F, a.in[I_WOUT] + (size_t)l * 1024 * 1024, 1024, kh * 512, nt * 256, wsp<bf16_t>(F, WS_WOUT) + ((size_t)l * 1024 + nt * 256) * 1024, 1024, [](int n) { return n; }); return; }
    r -= 8;
    if (r < 4) { const int which = r >> 1, kh = r & 1;
        transpose_stream<8>(F, a.in[which ? I_SW3 : I_SW1] + (size_t)l * 1024 * 256, 256, kh * 512, 0, wsp<bf16_t>(F, WS_WSH13) + (size_t)l * 512 * 1024, 1024,
                            [which](int n) { return 256 * (n >> 7) + (n & 127) + 128 * which; }); return; }
    r -= 4;
    transpose_stream<4>(F, a.in[I_SW2] + (size_t)l * 256 * 1024, 1024, 0, r * 256, wsp<bf16_t>(F, WS_WSH2) + ((size_t)l * 1024 + r * 256) * 256, 256, [](int n) { return n; });
}
__device__ __forceinline__ void copy_par(const Frame& F, const float* __restrict__ src, int off, int n, int slot) {
    if (F.bid % 12 != slot) return;
    float* dst = (float*)(F.ws + WS_PAR) + off; const int g = F.bid / 12, ng = (F.G - slot + 11) / 12;
#pragma unroll 4
    for (int i = g * NTHR + F.tid; i < n; i += ng * NTHR) dst[i] = src[i];
}
__device__ __forceinline__ void p0_wr(const Frame& F, const Args& a, int q) {
        const int l = q >> 4, k0 = (q & 15) * 64; float* tile = (float*)F.lds; const float* rw = a.in[I_RW] + (size_t)l * 1024 * 256; bf16_t* wr = wsp<bf16_t>(F, WS_WR) + (size_t)l * 256 * 3072;
        for (int i = F.tid; i < 64 * 64; i += NTHR) { const int r = i >> 6, c4 = (i & 63) * 4; const f32x4 v = *(const f32x4*)(rw + (size_t)(k0 + r) * 256 + c4);
            float* tp = tile + r * 261 + c4; tp[0] = v[0]; tp[1] = v[1]; tp[2] = v[2]; tp[3] = v[3]; }
        __syncthreads();
        for (int idx = F.tid; idx < 256 * 8; idx += NTHR) { const int n = idx >> 3, ks = (idx & 7) * 8; float x[8], lo[8];
#pragma unroll
            for (int j = 0; j < 8; ++j) x[j] = tile[(ks + j) * 261 + n];
            u32x4 hi = {cvtpk(x[0], x[1]), cvtpk(x[2], x[3]), cvtpk(x[4], x[5]), cvtpk(x[6], x[7])};
#pragma unroll
            for (int j = 0; j < 8; ++j) lo[j] = x[j] - __uint_as_float((j & 1) ? (hi[j >> 1] & 0xffff0000u) : (hi[j >> 1] << 16));
            u32x4 lw = {cvtpk(lo[0], lo[1]), cvtpk(lo[2], lo[3]), cvtpk(lo[4], lo[5]), cvtpk(lo[6], lo[7])};
            bf16_t* d = wr + (size_t)n * 3072 + k0 + ks; *(u32x4*)d = hi; *(u32x4*)(d + 1024) = hi; *(u32x4*)(d + 2048) = lw; }
        __syncthreads();
}
__device__ __forceinline__ void prologue_units(const Frame& F, const Args& a, int lsel, int pidx, int np) {
    constexpr int N_HF = 128, N_MODV = 96, N_TRS = 42, N_WR = 16; const int n_hyt = lsel == 0 ? 32 : 0, ntot = N_HF + N_MODV + N_TRS + N_WR + n_hyt + 1;
    for (int u = pidx; u < ntot; u += np) {
        if (u < N_HF) p0_hyfilt(F, a, lsel * N_HF + u);
        else if (u < N_HF + N_MODV) p0_modv(F, a, lsel * N_MODV + u - N_HF);
        else if (u < N_HF + N_MODV + N_TRS) p0_transpose_job(F, a, lsel * N_TRS + u - N_HF - N_MODV);
        else if (u < N_HF + N_MODV + N_TRS + N_WR) p0_wr(F, a, lsel * N_WR + u - N_HF - N_MODV - N_TRS);
        else if (u < N_HF + N_MODV + N_TRS + N_WR + n_hyt) p0_hytab(F, a, u - N_HF - N_MODV - N_TRS - N_WR);
        else p0_wg(F, a, lsel);
    }
}
__device__ __forceinline__ void phase_prologue(const Frame& F0, const Args& a) {
    const Frame F = phase_frame(F0);
    copy_par(F, a.in[I_N1G], PAR_N1G, 2048, 0); copy_par(F, a.in[I_N2G], PAR_N2G, 2048, 1); copy_par(F, a.in[I_MLGB], PAR_MLGB, 32, 2); copy_par(F, a.in[I_MLNG], PAR_MLNG, 512, 2);
    copy_par(F, a.in[I_DAQG], PAR_DAQG, 128, 3); copy_par(F, a.in[I_DAKG], PAR_DAKG, 128, 3); copy_par(F, a.in[I_DALAM], PAR_DALAM, 512, 4); copy_par(F, a.in[I_DASUB], PAR_DASUB, 256, 4);
    copy_par(F, a.in[I_HYCW], PAR_HYCW, 4608, 5); copy_par(F, a.in[I_HYCB], PAR_HYCB, 1536, 6); copy_par(F, a.in[I_HYSKIP], PAR_HYSKIP, 1024, 7); copy_par(F, a.in[I_RB], PAR_RB, 512, 7);
    for (int s4 = 0; s4 < 4; ++s4) copy_par(F, a.in[I_HYW3] + s4 * 32768, PAR_HYW3 + s4 * 32768, 32768, 8 + s4);
    { float* rope = (float*)(F.ws + WS_PAR) + PAR_ROPER;
      for (int i = F.bid * NTHR + F.tid; i < 96 * 16; i += F.G * NTHR) { const int pos = i >> 4, j = i & 15; const float ang = (float)(pos < 32 ? pos : pos - 32) * powf(10000.f, -(float)j / 16.f);
          rope[2 * i] = cosf(ang); rope[2 * i + 1] = sinf(ang); } }
    prologue_units(F, a, 0, F.bid, F.G);
}
constexpr int NCVTJ = NE * 6;
__device__ __forceinline__ int cvt_next(const Frame& F, int l) {
    volatile int* slot = (volatile int*)(F.lds + LDS_BYTES - 32);
    __syncthreads();
    if (F.tid == 0) *slot = (int)__hip_atomic_fetch_add((unsigned*)(F.ws + CTL_WQ) + 64 * (2 + l), 1u, __ATOMIC_RELAXED, __HIP_MEMORY_SCOPE_AGENT);
    __syncthreads();
    const int j = *slot;
    __syncthreads();
    return j;
}
__device__ __forceinline__ void cvt_pull(const Frame& F0, int l, int maxjobs) {
    const Frame F = phase_frame(F0);
    for (int k = 0; k < maxjobs; ++k) { const int j = cvt_next(F, l); if (j >= NCVTJ) break; expert_cvt_job(F, l, j); }
}
__device__ __forceinline__ void expert_cvt_unit(const Frame& F, int l, int q) {
    const int e = q / 24, x = q % 24;
    if (x < 16) { const int which = x >> 3, kt = x & 7;
        transpose_wide(F, (which ? F.ew3 : F.ew1) + ((size_t)l * NE + e) * 1024 * 256, 256, kt * 128, 0, wsp<bf16_t>(F, WS_WE13) + ((size_t)l * NE + e) * 512 * 1024, 1024,
                       [which](int n) { return 256 * (n >> 7) + (n & 127) + 128 * which; }); }
    else { const int y = x - 16, kt = y & 1, nt = y >> 1;
        transpose_wide(F, F.ew2 + ((size_t)l * NE + e) * 256 * 1024, 1024, kt * 128, nt * 256, wsp<bf16_t>(F, WS_WE2) + (((size_t)l * NE + e) * 1024 + nt * 256) * 256, 256,
                       [](int n) { return n; }); }
}

__device__ __forceinline__ void phase_norm1(const Frame& F0, int l) {
    const Frame F = phase_frame(F0);
    float* wg = (float*)F.lds;
    if (l < 2) { const float* wgs = wsp<float>(F, WS_WG) + l * 16 * 1024; for (int i = F.tid; i < 16 * 1024; i += NTHR) wg[i] = wgs[i]; }
    __syncthreads();
    const int lane = F.lane;
    float* XL = wsp<float>(F, WS_XL); bf16_t* H = wsp<bf16_t>(F, WS_H); float* GATE = wsp<float>(F, WS_GATE) + (size_t)(l & 1) * T * 16;
    const float* modv = wsp<float>(F, WS_MODV);
    const bf16_t* Y = wsp<bf16_t>(F, WS_Y); const bf16_t* YSH = wsp<bf16_t>(F, WS_YSH);
    for (int t = F.bid * 8 + F.wave; t < T; t += F.G * 8) {
        const int b = t / TB, p = t % TB; const bool isctx = p < CTX; const int mrow = isctx ? 8 : b;
        if (l == 2 && isctx) continue;
        f32x4 xv[4];
        if (l == 0) { const float* src = isctx ? F.ctx + ((size_t)b * CTX + p) * D : F.x + ((size_t)b * SEQ + (p - CTX)) * D;
#pragma unroll
            for (int i = 0; i < 4; ++i) xv[i] = *(const f32x4*)(src + 4 * lane + 256 * i);
        } else {
            const float* g2 = modv + ((size_t)(l - 1) * 9 + mrow) * 6144 + 5 * 1024;
#pragma unroll
            for (int i = 0; i < 4; ++i) { const int k = 4 * lane + 256 * i;
                xv[i] = *(const f32x4*)(XL + (size_t)t * D + k);
                f32x4 y = {0.f, 0.f, 0.f, 0.f};
#pragma unroll
                for (int s = 0; s < 8; ++s) { const u32x2 w = *(const u32x2*)(Y + ((size_t)t * 8 + s) * D + k);
                    y[0] += __uint_as_float(w[0] << 16); y[1] += __uint_as_float(w[0] & 0xffff0000u); y[2] += __uint_as_float(w[1] << 16); y[3] += __uint_as_float(w[1] & 0xffff0000u); }
                { const u32x2 w = *(const u32x2*)(YSH + (size_t)t * D + k);
                    y[0] += __uint_as_float(w[0] << 16); y[1] += __uint_as_float(w[0] & 0xffff0000u); y[2] += __uint_as_float(w[1] << 16); y[3] += __uint_as_float(w[1] & 0xffff0000u); }
                const f32x4 g = *(const f32x4*)(g2 + k);
                xv[i] += g * y; }
        }
        if (l == 2) { if (!isctx) { float* o = F.out + ((size_t)b * SEQ + (p - CTX)) * D;
#pragma unroll
                for (int i = 0; i < 4; ++i) *(f32x4*)(o + 4 * lane + 256 * i) = xv[i]; }
            continue; }
        const float* mv = modv + ((size_t)l * 9 + mrow) * 6144;
        const float* ng = par(F, PAR_N1G) + l * 1024;
        f32x4 pg[4], psh[4], psc[4];
#pragma unroll
        for (int i = 0; i < 4; ++i) { const int k = 4 * lane + 256 * i; pg[i] = *(const f32x4*)(ng + k); psh[i] = *(const f32x4*)(mv + k); psc[i] = *(const f32x4*)(mv + 1024 + k); }
        float ss = 0.f;
#pragma unroll
        for (int i = 0; i < 4; ++i) { *(f32x4*)(XL + (size_t)t * D + 4 * lane + 256 * i) = xv[i]; ss += xv[i][0] * xv[i][0] + xv[i][1] * xv[i][1] + xv[i][2] * xv[i][2] + xv[i][3] * xv[i][3]; }
        ss = wsum(ss, lane);
        const float rr = rsqrtf(ss * (1.f / 1024.f) + EPS);
        f32x4 hv[4];
#pragma unroll
        for (int i = 0; i < 4; ++i) { const int k = 4 * lane + 256 * i;
            const f32x4 g = pg[i], sh = psh[i], sc = psc[i];
            hv[i] = (xv[i] * rr) * g * (sc + 1.f) + sh;
            u32x2 w = {cvtpk(hv[i][0], hv[i][1]), cvtpk(hv[i][2], hv[i][3])};
            *(u32x2*)(H + (size_t)t * D + k) = w; }
        float ga[16];
#pragma unroll
        for (int g = 0; g < 16; ++g) { float a = 0.f;
#pragma unroll
            for (int i = 0; i < 4; ++i) { const f32x4 w = *(const f32x4*)(wg + g * 1024 + 4 * lane + 256 * i); a += hv[i][0] * w[0] + hv[i][1] * w[1] + hv[i][2] * w[2] + hv[i][3] * w[3]; }
            ga[g] = a; }
#pragma unroll
        for (int o = 32; o >= 1; o >>= 1) {
#pragma unroll
            for (int g = 0; g < 16; ++g) ga[g] += shx(ga[g], o, lane); }
        float myg = 0.f;
#pragma unroll
        for (int g = 0; g < 16; ++g) if (lane == g) myg = ga[g];
        if (lane < 16) GATE[(size_t)t * 16 + lane] = myg + par(F, PAR_MLGB)[l * 16 + lane];
    }
    __syncthreads();
}

#define EPI_ROWS(...) _Pragma("unroll") for (int ai = 0; ai < 2; ++ai) _Pragma("unroll") for (int m = 0; m < 4; ++m) { const int row = ai * 128 + wr * 64 + m * 16 + fr; __VA_ARGS__ }
#define EPI_COLS(...) _Pragma("unroll") for (int bj = 0; bj < 2; ++bj) { const int col = bj * 128 + wc * 32 + fq * 8; __VA_ARGS__ }
#define EPI_NOPRE struct Pre {}; __device__ __forceinline__ Pre pre(int, int, int, int) const { return Pre{}; } __device__ __forceinline__ void land(Pre&) const {}
struct EpiStoreBf16 { bf16_t* C; int ldc;
    EPI_NOPRE
    __device__ __forceinline__ void operator()(const f32x4 (&acc)[2][2][4][2], int wr, int wc, int fr, int fq, int ct, const Pre& pr) const {
        EPI_ROWS( bf16_t* rp = C + (size_t)row * ldc + ct * 256; EPI_COLS( const f32x4 v = acc[ai][bj][m][0], v2 = acc[ai][bj][m][1]; u32x4 w = {cvtpk(v[0], v[1]), cvtpk(v[2], v[3]), cvtpk(v2[0], v2[1]), cvtpk(v2[2], v2[3])}; *(u32x4*)(rp + col) = w; ) )
    } };
struct EpiStoreF32 { float* C; int ldc;
    EPI_NOPRE
    __device__ __forceinline__ void operator()(const f32x4 (&acc)[2][2][4][2], int wr, int wc, int fr, int fq, int ct, const Pre& pr) const {
        EPI_ROWS( float* rp = C + (size_t)row * ldc; EPI_COLS( *(f32x4*)(rp + col) = acc[ai][bj][m][0]; *(f32x4*)(rp + col + 4) = acc[ai][bj][m][1]; ) )
    } };
struct EpiStoreT { bf16_t* Ct; int ldt;
    EPI_NOPRE
    __device__ __forceinline__ void operator()(const f32x4 (&acc)[2][2][4][2], int wr, int wc, int fr, int fq, int ct, const Pre& pr) const {
#pragma unroll
        for (int bj = 0; bj < 2; ++bj)
#pragma unroll
        for (int n = 0; n < 2; ++n) { bf16_t* cp = Ct + (size_t)(bj * 128 + wc * 32 + n * 16 + fr) * ldt + wr * 64 + fq * 4;
#pragma unroll
            for (int ai = 0; ai < 2; ++ai)
#pragma unroll
            for (int m = 0; m < 4; ++m) { const f32x4 v = acc[ai][bj][m][n]; u32x2 w = {cvtpk(v[0], v[1]), cvtpk(v[2], v[3])}; *(u32x2*)(cp + ai * 128 + m * 16) = w; } }
    } };
struct EpiResidual { float* X; const float* g;
    EPI_NOPRE
    __device__ __forceinline__ void operator()(const f32x4 (&acc)[2][2][4][2], int wr, int wc, int fr, int fq, int ct, const Pre& pr) const {
        f32x4 gv[2][2];
        EPI_COLS( gv[bj][0] = *(const f32x4*)(g + col); gv[bj][1] = *(const f32x4*)(g + col + 4); )
        EPI_ROWS( float* rp = X + (size_t)row * 1024; EPI_COLS( f32x4 x = *(const f32x4*)(rp + col), x2 = *(const f32x4*)(rp + col + 4); x += gv[bj][0] * acc[ai][bj][m][0]; x2 += gv[bj][1] * acc[ai][bj][m][1];
            *(f32x4*)(rp + col) = x; *(f32x4*)(rp + col + 4) = x2; ) )
    } };
struct EpiSwiGLU { bf16_t* Gt;
    EPI_NOPRE
    __device__ __forceinline__ void operator()(const f32x4 (&acc)[2][2][4][2], int wr, int wc, int fr, int fq, int ct, const Pre& pr) const {
        EPI_ROWS( bf16_t* rp = Gt + (size_t)row * 256;
            { const f32x4 a = acc[ai][0][m][0], c = acc[ai][1][m][0], a2 = acc[ai][0][m][1], c2 = acc[ai][1][m][1];
                u32x4 w = {cvtpk(siluf_(a[0]) * c[0], siluf_(a[1]) * c[1]), cvtpk(siluf_(a[2]) * c[2], siluf_(a[3]) * c[3]), cvtpk(siluf_(a2[0]) * c2[0], siluf_(a2[1]) * c2[1]), cvtpk(siluf_(a2[2]) * c2[2], siluf_(a2[3]) * c2[3])};
                *(u32x4*)(rp + wc * 32 + fq * 8) = w; } )
    } };
struct EpiScatterY { bf16_t* Y; const int* list2; int cnt, pos0, dump;
    struct Pre { int slot[8]; float w[8]; };
    __device__ __forceinline__ Pre pre(int wr, int wc, int fr, int fq) const { Pre p;
#pragma unroll
        for (int i = 0; i < 8; ++i) { const i32x2 v = *(const i32x2*)(list2 + 2 * (size_t)min(pos0 + (i >> 2) * 128 + wr * 64 + (i & 3) * 16 + fr, cnt - 1)); p.slot[i] = pos0 + (i >> 2) * 128 + wr * 64 + (i & 3) * 16 + fr < cnt ? v[0] : dump; p.w[i] = __int_as_float(v[1]); }
        return p; }
    __device__ __forceinline__ void land(Pre& p) const {
#pragma unroll
        for (int i = 0; i < 8; ++i) asm volatile("" : "+v"(p.slot[i]), "+v"(p.w[i])); }
    __device__ __forceinline__ void operator()(const f32x4 (&acc)[2][2][4][2], int wr, int wc, int fr, int fq, int ct, const Pre& pr) const {
#pragma unroll
        for (int ai = 0; ai < 2; ++ai) {
#pragma unroll
            for (int m = 0; m < 4; ++m) {
                { bf16_t* rp = Y + (size_t)pr.slot[ai * 4 + m] * 1024 + ct * 256; const float wv = pr.w[ai * 4 + m];
                    EPI_COLS( const f32x4 v = acc[ai][bj][m][0] * wv, v2 = acc[ai][bj][m][1] * wv; u32x4 o = {cvtpk(v[0], v[1]), cvtpk(v[2], v[3]), cvtpk(v2[0], v2[1]), cvtpk(v2[2], v2[3])}; *(u32x4*)(rp + col) = o; ) } } }
    } };

struct EpiPrepQK { bf16_t* dst; const float* gain; const float* ropeR; const float* ropeC; float* ssq  ; int b, pb  , g0;
    EPI_NOPRE
    __device__ __forceinline__ void operator()(const f32x4 (&acc)[2][2][4][2], int wr, int wc, int fr, int fq, int ct, const Pre& pr) const {
        const int lane = fq * 16 + fr;
#pragma unroll
        for (int ai = 0; ai < 2; ++ai)
#pragma unroll
        for (int m = 0; m < 4; ++m) { const int row = ai * 128 + wr * 64 + m * 16 + fr;
#pragma unroll
            for (int bj = 0; bj < 2; ++bj) { const f32x4 a0 = acc[ai][bj][m][0], a1 = acc[ai][bj][m][1];
                float sq = a0[0] * a0[0] + a0[1] * a0[1] + a0[2] * a0[2] + a0[3] * a0[3] + a1[0] * a1[0] + a1[1] * a1[1] + a1[2] * a1[2] + a1[3] * a1[3];
                sq += shx(sq, 16, lane); sq += shx(sq, 32, lane);
                if (fq == 0) ssq[(row * 4 + bj * 2 + (wc >> 1)) * 2 + (wc & 1)] = sq; } }
        asm volatile("s_waitcnt lgkmcnt(0)" ::: "memory"); __builtin_amdgcn_s_barrier(); asm volatile("" ::: "memory");
        const int c8 = (wc & 1) * 32 + 8 * fq, part = c8 >> 4, e0 = c8 & 15; const float sg = (part & 1) ? 1.f : -1.f;
        const f32x4 g0v = *(const f32x4*)(gain + c8), g1v = *(const f32x4*)(gain + c8 + 4);
#pragma unroll
        for (int ai = 0; ai < 2; ++ai) {
        f32x4 csh[4][4];
        if (pb != 0) {
#pragma unroll
            for (int m = 0; m < 4; ++m) { const int sp = (pb - 1) * 256 + ai * 128 + wr * 64 + m * 16 + fr; const float* tb = (part < 2 ? ropeR + (sp >> 6) * 32 : ropeC + (sp & 63) * 32) + 2 * e0;
#pragma unroll
                for (int q = 0; q < 4; ++q) csh[m][q] = *(const f32x4*)(tb + 4 * q); } }
#pragma unroll
        for (int m = 0; m < 4; ++m) { const int row = ai * 128 + wr * 64 + m * 16 + fr, p = pb * 256 + row;
            f32x4 cs[4];
#pragma unroll
            for (int q = 0; q < 4; ++q) cs[q] = csh[m][q];
#pragma unroll
            for (int bj = 0; bj < 2; ++bj) { const int h = bj * 2 + (wc >> 1);
                const float tot = ssq[(row * 4 + h) * 2] + ssq[(row * 4 + h) * 2 + 1]; const float rr = rsqrtf(tot * (1.f / 64.f) + EPS);
                f32x4 v0 = acc[ai][bj][m][0] * rr * g0v, v1 = acc[ai][bj][m][1] * rr * g1v;
                if (pb != 0) { float v[8] = {v0[0], v0[1], v0[2], v0[3], v1[0], v1[1], v1[2], v1[3]};
#pragma unroll
                    for (int q = 0; q < 8; ++q) { const float o = shx(v[q], 32, lane); v[q] = v[q] * cs[q >> 1][(q & 1) * 2] + sg * o * cs[q >> 1][(q & 1) * 2 + 1]; }
                    v0 = (f32x4){v[0], v[1], v[2], v[3]}; v1 = (f32x4){v[4], v[5], v[6], v[7]}; }
                u32x4 w = {cvtpk(v0[0], v0[1]), cvtpk(v0[2], v0[3]), cvtpk(v1[0], v1[1]), cvtpk(v1[2], v1[3])};
                *(u32x4*)(dst + (((size_t)b * 8 + g0 + h) * TB + p) * 64 + c8) = w; } } }
    } };

__device__ __forceinline__ int label_panel(int xl, int i) { return i < 8 ? xl + 8 * (i < xl ? i : i + 1) : 9 * xl; }
template <class Make, class Run>
__device__ __forceinline__ void gemm_stream(int first, int stride, int n, Make make, Run run) {
    int u = first; if (u >= n) return;
    g8::GU cur = make(u); bool pf = false;
    while (u < n) { const int un = u + stride; const bool hn = un < n; const g8::GU nx = hn ? make(un) : cur; pf = run(u, un, cur, pf, hn, nx); cur = nx; u = un; }
}

__device__ __forceinline__ void phase_gemm_in(const Frame& F0, int l) {
    const Frame F = phase_frame(F0);
    const bf16_t* H = wsp<bf16_t>(F, WS_H); const bf16_t* W = wsp<bf16_t>(F, WS_WIN) + (size_t)l * NU * 1024; bf16_t* U = wsp<bf16_t>(F, WS_U); bf16_t* UH = wsp<bf16_t>(F, WS_UH);
    const int xl = F.bid & 7, rk = F.bid >> 3, nr = F.G >> 3;
    const int nctx = l == 1 ? 10 : 13;
    gemm_stream(rk, nr, 8 * 13 + nctx,
        [&](int j) { const int pan = label_panel(xl, j < 104 ? j / 13 : 8), tl = j < 104 ? j % 13 : j - 104; return g8::GU{H, W + (size_t)tl * 256 * 1024, pan * 256, 0, 0}; },
        [&](int j, int jn, const g8::GU& cur, bool pf, bool hn, const g8::GU& nx) -> bool { const int pan = label_panel(xl, j < 104 ? j / 13 : 8), tl = j < 104 ? j % 13 : j - 104; const int rb = pan * 256;
            const int tln = jn < 104 ? jn % 13 : jn - 104;
            const bool hn2 = hn && ((tl < 10) == (tln < 10));
            if (tl >= 4 && tl < 8) { EpiPrepQK E{wsp<bf16_t>(F, tl < 6 ? WS_QN : WS_KN), par(F, tl < 6 ? PAR_DAQG : PAR_DAKG) + l * 64, par(F, PAR_ROPER), par(F, PAR_ROPEC), (float*)(F.lds + 135168), pan / 9, pan % 9, (tl & 1) * 4};
                g8::gemm256<false, 0, true, 1, 16>(F.lds, cur, 1024, 1024, E, pf, hn2, nx); }
            else if (tl < 10) { EpiStoreBf16 E{U + (size_t)rb * NU + tl * 256, NU}; g8::gemm256<false, 0, true, 1, 16>(F.lds, cur, 1024, 1024, E, pf, hn2, nx); }
            else { EpiStoreT E{UH + (size_t)(tl - 10) * 256 * T + rb, T}; g8::gemm256<false, 0, false, 1, 16>(F.lds, cur, 1024, 1024, E, pf, hn2, nx); }
            return hn2; });
    __syncthreads();
    { const int n = 8 * 13 + nctx; if (n % nr != 0 && rk >= n % nr) cvt_pull(F0, l, 2); }
}
__device__ __forceinline__ void phase_gemm_out(const Frame& F0, const Args& a, int l) {
    const Frame F = phase_frame(F0);
    const bf16_t* A = wsp<bf16_t>(F, WS_MIX); const bf16_t* W = wsp<bf16_t>(F, WS_WOUT) + (size_t)l * 1024 * 1024; float* XL = wsp<float>(F, WS_XL);
    const float* modv = wsp<float>(F, WS_MODV);
    const int xl = F.bid & 7, rk = F.bid >> 3, nr = F.G >> 3;
    gemm_stream(rk, nr, (l == 1 ? 8 : 9) * 4,
        [&](int j) { const int pan = label_panel(xl, j / 4), tl = j % 4; return g8::GU{A, W + (size_t)tl * 256 * 1024, pan * 256, 0, 0}; },
        [&](int j, int jn, const g8::GU& cur, bool pf, bool hn, const g8::GU& nx) -> bool { const int pan = label_panel(xl, j / 4), tl = j % 4; const int rb = pan * 256; const int mrow = (pan % 9 == 0) ? 8 : pan / 9;
            EpiResidual E{XL + (size_t)rb * 1024 + tl * 256, modv + ((size_t)l * 9 + mrow) * 6144 + 2 * 1024 + tl * 256};
            g8::gemm256<false, 0, true, 1, 32>(F.lds, cur, 1024, 1024, E, pf, hn, nx); return hn; });
    __syncthreads();
    const int nu = (l == 1 ? 8 : 9) * 4;
    if (l == 0 && nu > nr && rk >= nu - nr) { const Frame F2 = phase_frame(F0); prologue_units(F2, a, 1, (rk - (nu - nr)) * 8 + xl, (nr - (nu - nr)) * 8);
        if ((rk - (nu - nr)) * 8 + xl >= 128) cvt_pull(F0, 1, 1); }
}


__device__ __forceinline__ void attn_unit(const Frame& F, int l, int b, int g, int qb) {
    const att::bf16* QN = (const att::bf16*)wsp<bf16_t>(F, WS_QN); const att::bf16* KN = (const att::bf16*)wsp<bf16_t>(F, WS_KN);
    const att::bf16* U = (const att::bf16*)wsp<bf16_t>(F, WS_U); float* O = wsp<float>(F, WS_O);
    const int p0 = qb < 8 ? CTX + qb * 256 : 0, seq = qb < 8 ? TB : CTX;
    const att::bf16* Qb = QN + (((size_t)b * 8 + g) * TB + p0) * 64;
    const att::bf16* Kh = KN + (((size_t)b * 8 + g) * TB) * 64;
    const att::bf16* Vh = U + ((size_t)b * TB) * NU + 2048 + (g >> 1) * 128;
    float* Ob = O + ((size_t)b * TB + p0) * 1024 + g * 128;
    att::attn_body64<64, 64, NU, 1024>(Qb, Kh, Vh, Ob, seq, F.lds);
    __syncthreads();
}

__device__ __forceinline__ f32x4 mm16(const bf16_t* A, int lda, const bf16_t* B, int ldb, int K, f32x4 acc, int lane) {
    const int r = lane & 15, q = lane >> 4;
#ifdef MM16_SCALAR
    for (int k0 = 0; k0 < K; k0 += 8) { const bf16x8 b = *(const bf16x8*)(B + r * ldb + k0);
#pragma unroll
        for (int i = 0; i < 4; ++i) { const bf16x8 a = *(const bf16x8*)(A + (q * 4 + i) * lda + k0);
#pragma unroll
            for (int j = 0; j < 8; ++j) acc[i] = fmaf(bf2f((bf16_t)a[j]), bf2f((bf16_t)b[j]), acc[i]); } }
    return acc;
#endif
    for (int k0 = 0; k0 < K; k0 += 32) {
        const bf16x8 a = *(const bf16x8*)(A + r * lda + k0 + q * 8), b = *(const bf16x8*)(B + r * ldb + k0 + q * 8);
        acc = __builtin_amdgcn_mfma_f32_16x16x32_bf16(a, b, acc, 0, 0, 0); }
    asm volatile("s_nop 15\n\ts_nop 15" : "+v"(acc));
    return acc;
}

__device__ __forceinline__ int mlstm_pos(int dir, int c, int r) { const int tau = c * 64 + r; return dir == 0 ? tau : (c < 4 ? 255 - tau : 2559 - tau); }
__device__ __forceinline__ void mlstm_unit(const Frame& F, int l, int b, int h, int dir) {
    constexpr int LDW = 72, NCH = 36, OPB = 4 * 64 * LDW;
    bf16_t* OP = (bf16_t*)F.lds;
    bf16_t* wkT = OP + 2 * OPB; bf16_t* Sb = wkT + 64 * LDW; bf16_t* Cb = Sb + 64 * LDW;
    float* fb = (float*)(Cb + 64 * LDW);
    float* tb = fb;
    float* ta = tb + NCH * 64;
    float* tm = ta + NCH * 64;
    float* cM = tm + NCH * 64;
    float* den = cM + 5 * 64; float* nq = den + 256; float* nvec = nq + 64;
    int tid = threadIdx.x; asm volatile("" : "+v"(tid)); const int lane = tid & 63, wave = __builtin_amdgcn_readfirstlane(tid >> 6);
    const bf16_t* U = wsp<bf16_t>(F, WS_U); const float* GATE = wsp<float>(F, WS_GATE) + (size_t)l * T * 16; float* OUT = wsp<float>(F, dir ? WS_HB : WS_HF);
    for (int c = wave; c < NCH; c += 8) { const size_t tk = (size_t)b * TB + mlstm_pos(dir, c, lane);
        const float gi = GATE[tk * 16 + dir * 8 + h], f = GATE[tk * 16 + dir * 8 + 4 + h];
        float bc = fminf(f, 0.f) - log1pf(expf(-fabsf(f)));
        for (int o = 1; o < 64; o <<= 1) { const float x = shup(bc, o, lane); if (lane >= o) bc += x; }
        const float av = gi - bc; float am = av;
        for (int o = 1; o < 64; o <<= 1) { const float x = shup(am, o, lane); if (lane >= o) am = fmaxf(am, x); }
        tb[c * 64 + lane] = bc; ta[c * 64 + lane] = av; tm[c * 64 + lane] = am;
        if (lane == 63) { cM[64 + c] = bc; cM[128 + c] = am; } }
    for (int i = tid; i < 64 * LDW; i += NTHR) Cb[i] = 0;
    if (tid < 64) nvec[tid] = 0.f;
    __syncthreads();
    if (tid == 0) { float m = -1e30f;
        for (int c = 0; c < NCH; ++c) { const float bend = cM[64 + c], mnew = fmaxf(bend + m, bend + cM[128 + c]); cM[c] = m; cM[192 + c] = expf(bend + m - mnew); cM[256 + c] = mnew; m = mnew; } }
    const int row = tid >> 3, seg = tid & 7;
    bf16x8 pq, pk, pv;
#define ML_LOAD(c) do { const bf16_t* up = U + ((size_t)b * TB + mlstm_pos(dir, (c), row)) * NU + h * 64 + seg * 8; pq = *(const bf16x8*)up; pk = *(const bf16x8*)(up + 256); pv = *(const bf16x8*)(up + 512); } while (0)
#define ML_WRITE(buf) do { bf16_t* qs_ = OP + (buf) * OPB; bf16_t* ks_ = qs_ + 64 * LDW; bf16_t* kT_ = ks_ + 64 * LDW; bf16_t* vT_ = kT_ + 64 * LDW; \
        *(bf16x8*)(qs_ + row * LDW + seg * 8) = pq; bf16x8 k8; \
        _Pragma("unroll") for (int j = 0; j < 8; ++j) { const bf16_t kk = f2bf(bf2f((bf16_t)pk[j]) * 0.125f); k8[j] = (short)kk; kT_[(seg * 8 + j) * LDW + row] = kk; vT_[(seg * 8 + j) * LDW + row] = (bf16_t)pv[j]; } \
        *(bf16x8*)(ks_ + row * LDW + seg * 8) = k8; } while (0)
    ML_LOAD(0); ML_WRITE(0); ML_LOAD(1);
    f32x4 Cst[2] = {{0.f, 0.f, 0.f, 0.f}, {0.f, 0.f, 0.f, 0.f}};
    __syncthreads();
    for (int c = 0; c < NCH; ++c) {
        const int cur = c & 1;
        const bf16_t* qs = OP + cur * OPB; const bf16_t* ks = qs + 64 * LDW; const bf16_t* kT = ks + 64 * LDW; const bf16_t* vT = kT + 64 * LDW;
        const float mc = cM[c], bend = cM[64 + c], decay = cM[192 + c], mnew = cM[256 + c];
        const float* ca = ta + c * 64; const float* cm = tm + c * 64; const float* cbv = tb + c * 64;
        f32x4 Cq[2];
#pragma unroll
        for (int ti = 0; ti < 2; ++ti) { const int tl = wave * 2 + ti, tr = tl >> 2, tc = tl & 3; const int r = lane & 15, q = lane >> 4;
            f32x4 raw = mm16(qs + tr * 16 * LDW, LDW, ks + tc * 16 * LDW, LDW, 64, (f32x4){0.f, 0.f, 0.f, 0.f}, lane);
            const int sI = tc * 16 + r; const float as = ca[sI];
#pragma unroll
            for (int i = 0; i < 4; ++i) { const int t = tr * 16 + q * 4 + i; float val = 0.f; if (sI <= t) val = raw[i] * fexp(as - fmaxf(mc, cm[t]));
                Sb[t * LDW + sI] = f2bf(val);
                const float rs = rowsum16(val);
                if (r == 0) den[t * 4 + tc] = rs; }
            Cq[ti] = mm16(qs + tr * 16 * LDW, LDW, Cb + tc * 16 * LDW, LDW, 64, (f32x4){0.f, 0.f, 0.f, 0.f}, lane); }
        float wsum_k;
        { const int d = tid >> 3; const bf16x8 kk = *(const bf16x8*)(kT + d * LDW + seg * 8); const f32x4 a0 = *(const f32x4*)(ca + seg * 8), a1 = *(const f32x4*)(ca + seg * 8 + 4);
          float wv[8];
#pragma unroll
          for (int j = 0; j < 8; ++j) wv[j] = bf2f((bf16_t)kk[j]) * fexp(bend + (j < 4 ? a0[j & 3] : a1[j & 3]) - mnew);
          u32x4 w = {cvtpk(wv[0], wv[1]), cvtpk(wv[2], wv[3]), cvtpk(wv[4], wv[5]), cvtpk(wv[6], wv[7])};
          *(u32x4*)(wkT + d * LDW + seg * 8) = w;
          wsum_k = 0.f;
#pragma unroll
          for (int j = 0; j < 8; ++j) wsum_k += __uint_as_float(j & 1 ? (w[j >> 1] & 0xffff0000u) : (w[j >> 1] << 16)); }
        { const bf16x8 qq = *(const bf16x8*)(qs + row * LDW + seg * 8); const f32x4 n0 = *(const f32x4*)(nvec + seg * 8), n1 = *(const f32x4*)(nvec + seg * 8 + 4);
          float acc = 0.f;
#pragma unroll
          for (int j = 0; j < 8; ++j) acc = fmaf(bf2f((bf16_t)qq[j]), j < 4 ? n0[j & 3] : n1[j & 3], acc);
          acc = sum8(acc); if (seg == 0) nq[row] = acc; }
        if (c + 1 < NCH) { ML_WRITE(cur ^ 1); if (c + 2 < NCH) ML_LOAD(c + 2); }
        __syncthreads();
#pragma unroll
        for (int ti = 0; ti < 2; ++ti) { const int tl = wave * 2 + ti, tr = tl >> 2, tc = tl & 3; const int r = lane & 15, q = lane >> 4;
            const f32x4 num = mm16(Sb + tr * 16 * LDW, LDW, vT + tc * 16 * LDW, LDW, 64, (f32x4){0.f, 0.f, 0.f, 0.f}, lane);
            const int e = tc * 16 + r;
#pragma unroll
            for (int i = 0; i < 4; ++i) { const int t = tr * 16 + q * 4 + i; const float mm_ = fmaxf(mc, cm[t]); const float cw = fexp(mc - mm_);
                const f32x4 d4 = *(const f32x4*)(den + t * 4);
                const float nn = num[i] + cw * Cq[ti][i], dn = ((d4[0] + d4[1]) + (d4[2] + d4[3])) + cw * nq[t];
                const float hv = nn * __builtin_amdgcn_rcpf(fmaxf(fabsf(dn), fexp(-(cbv[t] + mm_))));
                OUT[((size_t)b * TB + mlstm_pos(dir, c, t)) * 256 + h * 64 + e] = hv; }
            f32x4 cn = Cst[ti] * decay;
            cn = mm16(vT + tr * 16 * LDW, LDW, wkT + tc * 16 * LDW, LDW, 64, cn, lane);
            Cst[ti] = cn;
#pragma unroll
            for (int i = 0; i < 4; ++i) Cb[(tr * 16 + q * 4 + i) * LDW + tc * 16 + r] = f2bf(cn[i]); }
        { const float tot = sum8(wsum_k); if (seg == 0) nvec[row] = decay * nvec[row] + tot; }
        __syncthreads();
    }
#undef ML_LOAD
#undef ML_WRITE
}

template <int L>
__device__ __forceinline__ void hyena_unit(const Frame& F, int l, int c) {
    constexpr bool ISCTX = (L == CTX);
    constexpr int NTT = L >= NTHR ? L / NTHR : 1;
    float* z = (float*)F.lds;
    float* Kf = z + L * 8;
    float* w3c = Kf + 8 * L;
    float* red = w3c + 128;
    int tid = threadIdx.x; asm volatile("" : "+v"(tid)); const int lane = tid & 63, wave = __builtin_amdgcn_readfirstlane(tid >> 6);
    const bf16_t* U = wsp<bf16_t>(F, WS_UH); float* HYO = wsp<float>(F, WS_HYO);
    const float* cw = par(F, PAR_HYCW) + l * 3 * 768; const float* cb = par(F, PAR_HYCB) + l * 768;
    const float* hyt = wsp<float>(F, WS_HYT) + ((size_t)l * 2304 + (ISCTX ? 2048 : 0)) * 64;
    const float* w3 = par(F, PAR_HYW3) + (size_t)l * 64 * 1024;
    const float la = -3.0701134573253945f, lb = -15.350567286626973f;
    const float delta = fabsf(la + (float)c * ((lb - la) / 255.f));
#define TOKB(b) ((size_t)(b) * TB + (ISCTX ? 0 : CTX))
    auto sconv = [&](int col, int b, int t) -> float {
        const bf16_t* up = U + (size_t)col * T + TOKB(b) + t;
        const float u0 = t > 0 ? bf2f(up[-1]) : 0.f, u1 = bf2f(up[0]), u2 = t < L - 1 ? bf2f(up[1]) : 0.f;
        return u0 * cw[col] + u1 * cw[768 + col] + u2 * cw[1536 + col] + cb[col]; };
    for (int i = tid; i < L * 8; i += NTHR) { const int t = i >> 3, b = i & 7; z[i] = sconv(c, b, t); }
    __syncthreads();
    for (int o = 0; o < 2; ++o) {
        if (tid < 128) w3c[tid] = w3[(size_t)(tid & 63) * 1024 + (o * 2 + (tid >> 6)) * 256 + c];
        __syncthreads();
        float ssq = 0.f;
        for (int j = tid; j < L; j += NTHR) { const float* hr = hyt + (size_t)j * 64; float hf = 0.f, hb = 0.f;
#pragma unroll 8
            for (int i = 0; i < 64; ++i) { const float hv = hr[i]; hf = fmaf(hv, w3c[i], hf); hb = fmaf(hv, w3c[64 + i], hb); }
            const float win = expf(-((float)j / (float)(L - 1)) * delta) + 0.05f; hf *= win; hb *= win;
            if (j == 0) { Kf[L] = hf + hb; Kf[0] = 0.f; ssq += (hf + hb) * (hf + hb); }
            else { Kf[L + j] = hf; Kf[L - j] = hb; ssq += hf * hf + hb * hb; } }
        ssq = wsum(ssq, lane); if (lane == 0) red[wave] = ssq;
        __syncthreads();
        float tot = 0.f; for (int i = 0; i < 8; ++i) tot += red[i];
        const float scale = rsqrtf(tot + EPS);
        float acc[NTT][8];
#pragma unroll
        for (int i = 0; i < NTT; ++i)
#pragma unroll
            for (int b = 0; b < 8; ++b) acc[i][b] = 0.f;
        if (tid < L) {
#pragma unroll 2
            for (int s = 0; s < L; ++s) { const f32x4 za = *(const f32x4*)(z + s * 8), zb = *(const f32x4*)(z + s * 8 + 4);
#pragma unroll
                for (int i = 0; i < NTT; ++i) { const float kk = Kf[L + tid + NTHR * i - s];
                    acc[i][0] = fmaf(kk, za[0], acc[i][0]); acc[i][1] = fmaf(kk, za[1], acc[i][1]); acc[i][2] = fmaf(kk, za[2], acc[i][2]); acc[i][3] = fmaf(kk, za[3], acc[i][3]);
                    acc[i][4] = fmaf(kk, zb[0], acc[i][4]); acc[i][5] = fmaf(kk, zb[1], acc[i][5]); acc[i][6] = fmaf(kk, zb[2], acc[i][6]); acc[i][7] = fmaf(kk, zb[3], acc[i][7]); } }
        }
        __syncthreads();
        float* ybuf = Kf;
        if (tid < L) {
#pragma unroll
            for (int i = 0; i < NTT; ++i) { const int t = tid + NTHR * i;
                *(f32x4*)(ybuf + t * 8) = (f32x4){acc[i][0] * scale, acc[i][1] * scale, acc[i][2] * scale, acc[i][3] * scale};
                *(f32x4*)(ybuf + t * 8 + 4) = (f32x4){acc[i][4] * scale, acc[i][5] * scale, acc[i][6] * scale, acc[i][7] * scale}; }
        }
        __syncthreads();
        { const float skip = par(F, PAR_HYSKIP)[(l * 2 + o) * 256 + c];
#pragma unroll 2
          for (int i = tid; i < L * 8; i += NTHR) { const int t = i >> 3, b = i & 7;
              const float r = sconv((o + 1) * 256 + c, b, t) * (ybuf[i] + skip * z[i]);
              if (o == 0) z[i] = r; else HYO[(TOKB(b) + t) * 256 + c] = r; } }
        __syncthreads();
    }
#undef TOKB
}

__device__ __forceinline__ void hyena_mfma_unit(const Frame& F, int l, int c) {
    constexpr int L = SEQ, CPS = 2 * L + 32, OFF = L, ZR = L + 8;
    bf16_t* KC = (bf16_t*)F.lds;
    bf16_t* Z = KC + 8 * CPS;
    bf16_t* X = Z + 8 * ZR;
    float* w3c = (float*)(X + 8 * ZR);
    float* red = w3c + 128;
    int tid = threadIdx.x; asm volatile("" : "+v"(tid)); const int lane = tid & 63, wave = __builtin_amdgcn_readfirstlane(tid >> 6);
    const bf16_t* UH = wsp<bf16_t>(F, WS_UH); float* HYO = wsp<float>(F, WS_HYO);
    const float* cw = par(F, PAR_HYCW) + l * 3 * 768; const float* cb = par(F, PAR_HYCB) + l * 768;
    const float* hyt = wsp<float>(F, WS_HYT) + (size_t)l * 2304 * 64;
    const float* w3 = par(F, PAR_HYW3) + (size_t)l * 64 * 1024;
    const float la = -3.0701134573253945f, lb = -15.350567286626973f;
    const float delta = fabsf(la + (float)c * ((lb - la) / 255.f));
    auto load_conv = [&](int col, bf16_t* dst) {
        const bf16_t* src = UH + (size_t)col * T + CTX;
        const float w0 = cw[col], w1 = cw[768 + col], w2 = cw[1536 + col], bb = cb[col];
        for (int i = tid; i < 8 * (L / 8); i += NTHR) { const int b = i / (L / 8), t0 = (i % (L / 8)) * 8;
            const bf16_t* p = src + (size_t)b * TB + t0;
            const bf16x8 u = *(const bf16x8*)p;
            float x[10]; x[0] = t0 > 0 ? bf2f(p[-1]) : 0.f; x[9] = t0 + 8 < L ? bf2f(p[8]) : 0.f;
#pragma unroll
            for (int j = 0; j < 8; ++j) x[1 + j] = bf2f((bf16_t)u[j]);
            float o[8];
#pragma unroll
            for (int j = 0; j < 8; ++j) o[j] = x[j] * w0 + x[j + 1] * w1 + x[j + 2] * w2 + bb;
            u32x4 w = {cvtpk(o[0], o[1]), cvtpk(o[2], o[3]), cvtpk(o[4], o[5]), cvtpk(o[6], o[7])};
            *(u32x4*)(dst + b * ZR + t0) = w; } };
    load_conv(c, Z); load_conv(256 + c, X);
    for (int i = tid; i < 8 * 32; i += NTHR) { const int a = i >> 5, k = i & 31;
        if (k <= a) KC[a * CPS + k] = 0; if (k < 32 - a) KC[a * CPS + 2 * L + a + k] = 0; }
    const int r = lane & 31, g = lane >> 5, blk = r >> 3, bb_ = r & 7;
    const bf16_t* arow = KC + (r & 7) * CPS + OFF + 8 * g - 8 * (r >> 3);
    const bf16_t* zrow = Z + bb_ * ZR + 8 * g;
    const int tb0 = 256 * wave + 32 * blk, tb1 = tb0 + 128;
    f32x16 y0, y1;
    for (int o = 0; o < 2; ++o) {
        __syncthreads();
        float ssq = 0.f;
        {
            const float* kfb = wsp<float>(F, WS_KF) + ((size_t)(l * 2 + o) * 256) * 4096; const float* kf = kfb + kf_off(c, tid * 8);
            const f32x4 k0 = *(const f32x4*)kf, k1 = *(const f32x4*)(kf + 4); const float hb0 = kfb[kf_off(c, 0)];
            float kv[8] = {k0[0], k0[1], k0[2], k0[3], k1[0], k1[1], k1[2], k1[3]};
#pragma unroll
            for (int j = 0; j < 8; ++j) { const int idx = tid * 8 + j; float v = kv[j];
                if (idx == 0) continue;
                if (idx == L) v += hb0;
                ssq += v * v; const bf16_t vb = f2bf(v); const int d = idx - L;
#pragma unroll
                for (int a = 0; a < 8; ++a) KC[a * CPS + OFF + a - d] = vb; } }
        ssq = wsum(ssq, lane); if (lane == 0) red[wave] = ssq;
        __syncthreads();
        float tot = 0.f; for (int i = 0; i < 8; ++i) tot += red[i];
        const float scale = rsqrtf(tot + EPS);
        y0 = f32x16{}; y1 = f32x16{};
        const int Dlo = 256 * wave - (L - 16), Dhi = 256 * wave + 224;
#define HY_LOAD(AF, B0, B1, DD) do { AF = *(const bf16x8*)(arow - (DD)); const int _s0 = tb0 - (DD), _s1 = tb1 - (DD); \
            B0 = *(const bf16x8*)(zrow + min(max(_s0, 0), L - 16)); B1 = *(const bf16x8*)(zrow + min(max(_s1, 0), L - 16)); \
            if ((unsigned)_s0 >= (unsigned)L) B0 = bf16x8{}; if ((unsigned)_s1 >= (unsigned)L) B1 = bf16x8{}; } while (0)
        bf16x8 afA, b0A, b1A, afB, b0B, b1B;
        HY_LOAD(afA, b0A, b1A, Dlo);
#pragma unroll 1
        for (int Dd = Dlo; Dd <= Dhi; Dd += 32) {
            HY_LOAD(afB, b0B, b1B, Dd + 16);
            y0 = __builtin_amdgcn_mfma_f32_32x32x16_bf16(afA, b0A, y0, 0, 0, 0);
            y1 = __builtin_amdgcn_mfma_f32_32x32x16_bf16(afA, b1A, y1, 0, 0, 0);
            HY_LOAD(afA, b0A, b1A, min(Dd + 32, Dhi));
            y0 = __builtin_amdgcn_mfma_f32_32x32x16_bf16(afB, b0B, y0, 0, 0, 0);
            y1 = __builtin_amdgcn_mfma_f32_32x32x16_bf16(afB, b1B, y1, 0, 0, 0); }
#undef HY_LOAD
        asm volatile("s_nop 15\n\ts_nop 15" : "+v"(y0), "+v"(y1));
        const float skip = par(F, PAR_HYSKIP)[(l * 2 + o) * 256 + c];
        float res[2][16];
#pragma unroll
        for (int nt = 0; nt < 2; ++nt)
#pragma unroll
        for (int rq = 0; rq < 4; ++rq) { const int t4 = (nt ? tb1 : tb0) + 8 * rq + 4 * g;
            const u32x2 xw = *(const u32x2*)(X + bb_ * ZR + t4), zw = *(const u32x2*)(Z + bb_ * ZR + t4);
            const float xv[4] = {__uint_as_float(xw[0] << 16), __uint_as_float(xw[0] & 0xffff0000u), __uint_as_float(xw[1] << 16), __uint_as_float(xw[1] & 0xffff0000u)};
            const float zv[4] = {__uint_as_float(zw[0] << 16), __uint_as_float(zw[0] & 0xffff0000u), __uint_as_float(zw[1] << 16), __uint_as_float(zw[1] & 0xffff0000u)};
#pragma unroll
            for (int k = 0; k < 4; ++k) res[nt][rq * 4 + k] = xv[k] * ((nt ? y1[rq * 4 + k] : y0[rq * 4 + k]) * scale + skip * zv[k]); }
        __syncthreads();
        if (o == 0) {
#pragma unroll
            for (int nt = 0; nt < 2; ++nt)
#pragma unroll
            for (int rq = 0; rq < 4; ++rq) { const int t4 = (nt ? tb1 : tb0) + 8 * rq + 4 * g;
                u32x2 w = {cvtpk(res[nt][rq * 4], res[nt][rq * 4 + 1]), cvtpk(res[nt][rq * 4 + 2], res[nt][rq * 4 + 3])};
                *(u32x2*)(Z + bb_ * ZR + t4) = w; }
            load_conv(512 + c, X);
        } else {
#pragma unroll
            for (int nt = 0; nt < 2; ++nt)
#pragma unroll
            for (int rq = 0; rq < 4; ++rq) { const int t4 = (nt ? tb1 : tb0) + 8 * rq + 4 * g;
#pragma unroll
                for (int k = 0; k < 4; ++k) HYO[((size_t)bb_ * TB + CTX + t4 + k) * 256 + c] = res[nt][rq * 4 + k]; }
        }
    }
    __syncthreads();
}

__device__ __forceinline__ void phase_mlstm_only(const Frame& F0, int l) {
    const Frame F = phase_frame(F0);
    for (int v = (F.bid + 131) % F.G; v < 64; v += F.G) mlstm_unit(F, l, v >> 3, (v >> 1) & 3, v & 1);
}
__device__ __forceinline__ void phase_mixers(const Frame& F0, int l) {
    const Frame F = phase_frame(F0);
    constexpr int N_ML = 64, N_AT = 512, N_HL = 256, N_AC = 64, N_HC = 256, NMIX = N_ML + N_AT + N_HL + N_AC + N_HC, NCVT = NE * 6, NTOT = NMIX + NCVT;
    static_assert(NMIX == 384 * 3 && NCVT == 384 * 4, "queue interleave: 384 groups of 3 mixer units + 3 conversion slots, then 384 trailing conversion slots (short jobs fill the phase's tail)");
    unsigned* head = (unsigned*)(F.ws + CTL_WQ) + 64 * l;
    volatile int* slot = (volatile int*)(F.lds + LDS_BYTES - 32);
#ifndef MIXMASK
#define MIXMASK 31
#endif
#ifndef MIXREP
#define MIXREP 0
#endif
    for (;;) {
        if (F.tid == 0) { const int v0 = (int)__hip_atomic_fetch_add(head, 1u, __ATOMIC_RELAXED, __HIP_MEMORY_SCOPE_AGENT); slot[0] = v0;
            if (v0 < NTOT && (v0 >= 384 * 6 || v0 % 6 >= 3)) slot[1] = (int)__hip_atomic_fetch_add(head + 64 * 2, 1u, __ATOMIC_RELAXED, __HIP_MEMORY_SCOPE_AGENT); }
        __syncthreads();
        int v = slot[0]; const int cj = slot[1];
        __syncthreads();
        if (v >= NTOT) break;
        { const int grp = v / 6, w = v % 6; if (v >= 384 * 6 || w >= 3) { if (cj < NCVTJ) { expert_cvt_job(F, l, cj); if (MIXREP & 8) expert_cvt_job(F, l, cj); } continue; } v = grp * 3 + w; }
        if (v < N_ML) { if (MIXMASK & 4) { mlstm_unit(F, l, v >> 3, (v >> 1) & 3, v & 1); if (MIXREP & 2) mlstm_unit(F, l, v >> 3, (v >> 1) & 3, v & 1); } continue; } v -= N_ML;
        if (v < N_AT) { if (MIXMASK & 2) { attn_unit(F, l, v >> 6, (v >> 3) & 7, v & 7); if (MIXREP & 1) attn_unit(F, l, v >> 6, (v >> 3) & 7, v & 7); } continue; } v -= N_AT;
        if (v < N_HL) { if (MIXMASK & 1) { hyena_mfma_unit(F, l, v); if (MIXREP & 4) hyena_mfma_unit(F, l, v); } continue; } v -= N_HL;
        if (l == 1) continue;
        if (v < N_AC) { if (MIXMASK & 8) attn_unit(F, l, v >> 3, v & 7, 8); continue; } v -= N_AC;
        if (MIXMASK & 16) hyena_unit<CTX>(F, l, v);
    }
}

__device__ __forceinline__ void phase_finish(const Frame& F0, int l) {
    const Frame F = phase_frame(F0);
    const int lane = F.lane;
    const float* lp = par(F, PAR_DALAM) + l * 256;
    const float la = wsum(lp[lane] * lp[64 + lane], lane), lb = wsum(lp[128 + lane] * lp[192 + lane], lane);
    const float lam_init = 0.8f - 0.6f * expf(-0.3f * (float)l);
    const float lam = expf(la) - expf(lb) + lam_init;
    const float* HF = wsp<float>(F, WS_HF); const float* HB = wsp<float>(F, WS_HB); const float* O = wsp<float>(F, WS_O);
    const bf16_t* U = wsp<bf16_t>(F, WS_U); bf16_t* MIX = wsp<bf16_t>(F, WS_MIX); const float* HYO = wsp<float>(F, WS_HYO);
    const f32x4 mg = *(const f32x4*)(par(F, PAR_MLNG) + l * 256 + 4 * lane);
    const float sg0 = par(F, PAR_DASUB)[l * 128 + 2 * lane] * (1.f - lam_init), sg1 = par(F, PAR_DASUB)[l * 128 + 2 * lane + 1] * (1.f - lam_init);
    typedef float f32x2 __attribute__((ext_vector_type(2)));
    for (int t = F.bid * 8 + F.wave; t < T; t += F.G * 8) {
        if (l == 1 && t % TB < CTX) continue;
        const f32x4 hf = *(const f32x4*)(HF + (size_t)t * 256 + 4 * lane), hb = *(const f32x4*)(HB + (size_t)t * 256 + 4 * lane);
        const u32x2 ow = *(const u32x2*)(U + (size_t)t * NU + 768 + 4 * lane);
        const f32x4 hy = *(const f32x4*)(HYO + (size_t)t * 256 + 4 * lane);
        f32x2 oa[4], ob[4];
#pragma unroll
        for (int h = 0; h < 4; ++h) { const float* op = O + (size_t)t * 1024 + h * 256 + 2 * lane; oa[h] = *(const f32x2*)op; ob[h] = *(const f32x2*)(op + 128); }
        const f32x4 hv = hf + hb;
        float d0[4], d1[4], sq[4];
#pragma unroll
        for (int h = 0; h < 4; ++h) { d0[h] = oa[h][0] - lam * ob[h][0]; d1[h] = oa[h][1] - lam * ob[h][1]; sq[h] = d0[h] * d0[h] + d1[h] * d1[h]; }
#pragma unroll
        for (int o = 32; o >= 1; o >>= 1) {
#pragma unroll
            for (int h = 0; h < 4; ++h) sq[h] += shx(sq[h], o, lane); }
        {
          float s16 = hv[0] * hv[0] + hv[1] * hv[1] + hv[2] * hv[2] + hv[3] * hv[3];
          s16 += shx(s16, 1, lane); s16 += shx(s16, 2, lane); s16 += shx(s16, 4, lane); s16 += shx(s16, 8, lane);
          const float rr = rsqrtf(s16 * (1.f / 64.f) + EPS);
          const float o0 = __uint_as_float(ow[0] << 16), o1 = __uint_as_float(ow[0] & 0xffff0000u), o2 = __uint_as_float(ow[1] << 16), o3 = __uint_as_float(ow[1] & 0xffff0000u);
          const float y0 = sigmoidf_(o0) * (hv[0] * rr * mg[0]), y1 = sigmoidf_(o1) * (hv[1] * rr * mg[1]), y2 = sigmoidf_(o2) * (hv[2] * rr * mg[2]), y3 = sigmoidf_(o3) * (hv[3] * rr * mg[3]);
          u32x2 w = {cvtpk(y0, y1), cvtpk(y2, y3)};
          *(u32x2*)(MIX + (size_t)t * 1024 + 4 * lane) = w;
          u32x2 wy = {cvtpk(hy[0], hy[1]), cvtpk(hy[2], hy[3])};
          *(u32x2*)(MIX + (size_t)t * 1024 + 768 + 4 * lane) = wy; }
#pragma unroll
        for (int h = 0; h < 4; ++h) { const float rr = rsqrtf(sq[h] * (1.f / 128.f) + EPS);
            *(unsigned*)(MIX + (size_t)t * 1024 + 256 + h * 128 + 2 * lane) = cvtpk(d0[h] * rr * sg0, d1[h] * rr * sg1); }
    }
}

__device__ __forceinline__ void phase_norm2(const Frame& F0, int l) {
    const Frame F = phase_frame(F0);
    const int lane = F.lane;
    const float* XL = wsp<float>(F, WS_XL); bf16_t* H2X = wsp<bf16_t>(F, WS_H2X); const float* modv = wsp<float>(F, WS_MODV); const float* ng = par(F, PAR_N2G) + l * 1024;
    for (int t = F.bid * 8 + F.wave; t < T; t += F.G * 8) { const int b = t / TB, p = t % TB; const int mrow = p < CTX ? 8 : b;
        if (l == 1 && p < CTX) continue;
        const float* mv = modv + ((size_t)l * 9 + mrow) * 6144 + 3 * 1024;
        f32x4 xv[4]; float ss = 0.f;
#pragma unroll
        for (int i = 0; i < 4; ++i) { xv[i] = *(const f32x4*)(XL + (size_t)t * D + 4 * lane + 256 * i); ss += xv[i][0] * xv[i][0] + xv[i][1] * xv[i][1] + xv[i][2] * xv[i][2] + xv[i][3] * xv[i][3]; }
        ss = wsum(ss, lane); const float rr = rsqrtf(ss * (1.f / 1024.f) + EPS);
#pragma unroll
        for (int i = 0; i < 4; ++i) { const int k = 4 * lane + 256 * i;
            const f32x4 g = *(const f32x4*)(ng + k), sh = *(const f32x4*)(mv + k), sc = *(const f32x4*)(mv + 1024 + k);
            const f32x4 hv = (xv[i] * rr) * g * (sc + 1.f) + sh;
            const unsigned h01 = cvtpk(hv[0], hv[1]), h23 = cvtpk(hv[2], hv[3]);
            const float l0 = hv[0] - __uint_as_float(h01 << 16), l1 = hv[1] - __uint_as_float(h01 & 0xffff0000u), l2 = hv[2] - __uint_as_float(h23 << 16), l3 = hv[3] - __uint_as_float(h23 & 0xffff0000u);
            u32x2 wh = {h01, h23}, wl = {cvtpk(l0, l1), cvtpk(l2, l3)};
            *(u32x2*)(H2X + (size_t)t * 2048 + k) = wh; *(u32x2*)(H2X + (size_t)t * 2048 + 1024 + k) = wl; } }
}
__device__ __forceinline__ void phase_rgemm(const Frame& F0, int l) {
    const Frame F = phase_frame(F0);
    const bf16_t* A = wsp<bf16_t>(F, WS_H2X); const bf16_t* W = wsp<bf16_t>(F, WS_WR) + (size_t)l * 256 * 3072; float* LOG = wsp<float>(F, WS_LOG);
    bf16_t* GSH = wsp<bf16_t>(F, WS_GSH); const bf16_t* WS = wsp<bf16_t>(F, WS_WSH13) + (size_t)l * 512 * 1024;
    const int xl = F.bid & 7, rk = F.bid >> 3, nr = F.G >> 3, npan = l == 1 ? 8 : 9;
    const bool split = nr > npan;
    if (!split || rk < npan) {
        gemm_stream(rk, split ? npan : nr, npan,
            [&](int j) { return g8::GU{A, W, label_panel(xl, j) * 256, 0, 0}; },
            [&](int j, int jn, const g8::GU& cur, bool pf, bool hn, const g8::GU& nx) -> bool { EpiStoreF32 E{LOG + (size_t)label_panel(xl, j) * 256 * 256, 256}; g8::gemm256<false, 32, true, 1, 32>(F.lds, cur, 2048, 3072, E, pf, hn, nx); return hn; });
        __syncthreads(); }
    if (!split || rk >= npan) {
        gemm_stream(split ? rk - npan : rk, split ? nr - npan : nr, npan * 2,
            [&](int v) { const int pan = label_panel(xl, v >> 1), p = v & 1; return g8::GU{A, WS + (size_t)p * 256 * 1024, pan * 256, 0, 0}; },
            [&](int v, int jn, const g8::GU& cur, bool pf, bool hn, const g8::GU& nx) -> bool { const int pan = label_panel(xl, v >> 1), p = v & 1; EpiSwiGLU E{GSH + (size_t)pan * 256 * 256 + p * 128};
                g8::gemm256<false, 0, true, 1, 8>(F.lds, cur, 2048, 1024, E, pf, hn, nx); return hn; });
        __syncthreads();
        if (split && l == 0) cvt_pull(F0, 1, rk - npan >= npan * 2 ? 3 : 1); }
}
__device__ __forceinline__ void phase_topk(const Frame& F0, int l) {
    const Frame F = phase_frame(F0);
    const int lane = F.lane;
    const float* LOG = wsp<float>(F, WS_LOG); int* EIDX = wsp<int>(F, WS_EIDX); float* WSLOT = wsp<float>(F, WS_WSLOT);
    const f32x4 rbv = *(const f32x4*)(par(F, PAR_RB) + l * 256 + 4 * lane);
    int* hist = (int*)F.lds;
    if (F.tid < NE) hist[F.tid] = 0;
    __syncthreads();
    const int segt = (T + F.G - 1) / F.G, t0 = F.bid * segt;
    constexpr int NTK = 3;
    for (int i0 = F.wave; i0 < segt; i0 += 8 * NTK) {
        int tt[NTK]; bool act[NTK]; f32x4 lgv[NTK];
#pragma unroll
        for (int u = 0; u < NTK; ++u) { const int i = i0 + 8 * u, t = t0 + i; act[u] = i < segt && t < T; tt[u] = act[u] ? t : t0;
            if (act[u] && l == 1 && t % TB < CTX) { if (lane < 8) EIDX[(size_t)t * 8 + lane] = -1; act[u] = false; }
            lgv[u] = *(const f32x4*)(LOG + (size_t)tt[u] * 256 + 4 * lane); }
        float sc[NTK][4], sel[NTK][4], m1[NTK], m2[NTK];
#pragma unroll
        for (int u = 0; u < NTK; ++u) {
#pragma unroll
            for (int j = 0; j < 4; ++j) { sc[u][j] = 1.f / (1.f + expf(-lgv[u][j])); sel[u][j] = sc[u][j] + rbv[j]; }
            m1[u] = -INFINITY; m2[u] = -INFINITY;
#pragma unroll
            for (int j = 0; j < 4; ++j) { const float v = sel[u][j]; if (v > m1[u]) { m2[u] = m1[u]; m1[u] = v; } else if (v > m2[u]) m2[u] = v; } }
#pragma unroll
        for (int off = 1; off <= 4; off <<= 1) {
#pragma unroll
            for (int u = 0; u < NTK; ++u) { const float o1 = shx(m1[u], off, lane), o2 = shx(m2[u], off, lane);
                const float n1 = fmaxf(m1[u], o1), n2 = fmaxf(fminf(m1[u], o1), fmaxf(m2[u], o2)); m1[u] = n1; m2[u] = n2; } }
        const int g = lane >> 3; int rank[NTK]; float gs[NTK];
#pragma unroll
        for (int u = 0; u < NTK; ++u) { gs[u] = m1[u] + m2[u]; rank[u] = 0; }
#pragma unroll
        for (int gp = 0; gp < 8; ++gp) {
#pragma unroll
            for (int u = 0; u < NTK; ++u) { const float s2 = shi(gs[u], gp * 8); rank[u] += (s2 > gs[u] || (s2 == gs[u] && gp < g)) ? 1 : 0; } }
#pragma unroll
        for (int u = 0; u < NTK; ++u) if (rank[u] >= 4) {
#pragma unroll
            for (int j = 0; j < 4; ++j) sel[u][j] = -INFINITY; }
        int myidx[NTK]; float myw[NTK], wtot[NTK];
#pragma unroll
        for (int u = 0; u < NTK; ++u) { myidx[u] = 0; myw[u] = 0.f; wtot[u] = 0.f; }
#pragma unroll 1
        for (int k = 0; k < 8; ++k) { float bv[NTK]; int bi[NTK];
#pragma unroll
            for (int u = 0; u < NTK; ++u) { bv[u] = sel[u][0]; bi[u] = lane * 4;
#pragma unroll
                for (int j = 1; j < 4; ++j) if (sel[u][j] > bv[u]) { bv[u] = sel[u][j]; bi[u] = lane * 4 + j; } }
#pragma unroll
            for (int off = 32; off >= 1; off >>= 1) {
#pragma unroll
                for (int u = 0; u < NTK; ++u) { const float ov = shx(bv[u], off, lane); const int oi = shx(bi[u], off, lane); if (ov > bv[u] || (ov == bv[u] && oi < bi[u])) { bv[u] = ov; bi[u] = oi; } } }
            float wsc[NTK];
#pragma unroll
            for (int u = 0; u < NTK; ++u) { const bool own = (bi[u] >> 2) == lane; const int jj = bi[u] & 3; wsc[u] = 0.f;
#pragma unroll
                for (int j = 0; j < 4; ++j) if (own && jj == j) { wsc[u] = sc[u][j]; sel[u][j] = -INFINITY; } }
#pragma unroll
            for (int u = 0; u < NTK; ++u) { wsc[u] = shi(wsc[u], bi[u] >> 2); wtot[u] += wsc[u]; if (lane == k) { myidx[u] = bi[u]; myw[u] = wsc[u]; } } }
#pragma unroll
        for (int u = 0; u < NTK; ++u) { const float w = myw[u] / wtot[u] * 2.5f;
            if (act[u] && lane < 8) { EIDX[(size_t)tt[u] * 8 + lane] = myidx[u]; WSLOT[(size_t)tt[u] * 8 + lane] = w; atomicAdd(&hist[myidx[u]], 1); } }
    }
    __syncthreads();
    if (F.tid < NE) wsp<int>(F, WS_HIST)[F.bid * NE + F.tid] = hist[F.tid];
}

__device__ __forceinline__ void phase_lists(const Frame& F0, int l) {
    const Frame F = phase_frame(F0);
    int* base = (int*)F.lds; int* part = base + NE; int* sege = part + NE; constexpr int MAXS = 2304;
    const int* EIDX = wsp<int>(F, WS_EIDX); const float* WSLOT = wsp<float>(F, WS_WSLOT); const int* HIST = wsp<int>(F, WS_HIST); int* LIST = wsp<int>(F, WS_LIST);
    const int segt = (T + F.G - 1) / F.G, s0 = F.bid * segt * 8, ns = max(0, min(segt * 8, T * 8 - s0));
    const int e = F.tid & 255, half = F.tid >> 8;
    int acc = 0;
#pragma unroll 8
    for (int b = half; b < F.bid; b += 2) acc += HIST[b * NE + e];
    if (half) part[e] = acc;
    for (int i = F.tid; i < ns; i += NTHR) sege[i] = EIDX[s0 + i];
    __syncthreads();
    if (!half) { acc += part[e]; base[e] = acc; if (F.bid == F.G - 1) ((int*)(F.ws + CTL_CNT))[l * 256 + e] = acc + HIST[F.bid * NE + e]; }
    __syncthreads();
    for (int i = F.tid; i < ns; i += NTHR) { const int me = sege[i]; if (me < 0) continue;
        int rank = 0;
        for (int j = (i & ~7) - 8; j >= 0; j -= 8) {
            const i32x4 a = *(const i32x4*)(sege + j), c = *(const i32x4*)(sege + j + 4);
            rank += (a[0] == me) + (a[1] == me) + (a[2] == me) + (a[3] == me) + (c[0] == me) + (c[1] == me) + (c[2] == me) + (c[3] == me); }
        i32x2 o = {s0 + i, __float_as_int(WSLOT[s0 + i])}; *(i32x2*)(LIST + 2 * ((size_t)me * T + base[me] + rank)) = o; }
}

__device__ __forceinline__ void moe_prefix(const Frame& F, int l, int* pre) {
    const int* cnt = (const int*)(F.ws + CTL_CNT) + l * 256;
    int* nb = pre + NE + 8;
    if (F.tid < NE) nb[F.tid] = (cnt[(F.tid & 31) * 8 + (F.tid >> 5)] + 255) >> 8;
    __syncthreads();
    if (F.tid <= NE) { int sum = 0; for (int j = 0; j < F.tid; ++j) sum += nb[j]; pre[F.tid] = sum; }
    __syncthreads();
}
__device__ __forceinline__ int moe_find(const int* pre, int q) { int lo = 0, hi = NE; while (hi - lo > 1) { const int mid = (lo + hi) >> 1; if (__builtin_amdgcn_readfirstlane(pre[mid]) <= q) lo = mid; else hi = mid; } return __builtin_amdgcn_readfirstlane(lo); }
#define RFL(x) __builtin_amdgcn_readfirstlane(x)

__device__ __forceinline__ void phase_moe1(const Frame& F0, int l) {
    const Frame F = phase_frame(F0);
    int* pre = (int*)(F.lds + 131072);
    moe_prefix(F, l, pre);
    const int nexp = RFL(pre[NE]); const int* cnt = (const int*)(F.ws + CTL_CNT) + l * 256; const int* LIST = wsp<int>(F, WS_LIST);
    const bf16_t* H = wsp<bf16_t>(F, WS_H2X); bf16_t* G = wsp<bf16_t>(F, WS_G); bf16_t* GSH = wsp<bf16_t>(F, WS_GSH);
    const bf16_t* WE = wsp<bf16_t>(F, WS_WE13) + (size_t)l * NE * 512 * 1024; const bf16_t* WS = wsp<bf16_t>(F, WS_WSH13) + (size_t)l * 512 * 1024;
    const int xl = F.bid & 7, rk = F.bid >> 3, nr = F.G >> 3; const int q0 = RFL(pre[32 * xl]), nq = RFL(pre[32 * xl + 32]) - q0;
    gemm_stream(rk, nr, nq * 2,
        [&](int j) { const int q = q0 + (j >> 1), p = j & 1; const int ei = moe_find(pre, q); const int e = (ei & 31) * 8 + (ei >> 5); const int pe = RFL(pre[ei]); const int rb = q - pe, c = RFL(cnt[e]); const int* le = LIST + (size_t)e * T * 2;
            int tz = threadIdx.x; asm volatile("" : "+v"(tz)); const int r0 = g8::stage_row(tz, 0), r1 = g8::stage_row(tz, 1);
            const int p00 = min(rb * 256 + r0, c - 1), p01 = min(rb * 256 + r1, c - 1), p10 = min(rb * 256 + 128 + r0, c - 1), p11 = min(rb * 256 + 128 + r1, c - 1);
            return g8::GU{H, WE + ((size_t)e * 512 + p * 256) * 1024, 0, (le[2 * p00] >> 3) | ((le[2 * p01] >> 3) << 16), (le[2 * p10] >> 3) | ((le[2 * p11] >> 3) << 16)}; },
        [&](int j, int jn, const g8::GU& cur, bool pf, bool hn, const g8::GU& nx) -> bool { const int q = q0 + (j >> 1), p = j & 1;
            EpiSwiGLU E{G + (size_t)q * 256 * 256 + p * 128};
            g8::gemm256<true, 0, true, 1, 8>(F.lds, cur, 2048, 1024, E, pf, hn, nx); return hn; });
    __syncthreads();
}
__device__ __forceinline__ void phase_moe2(const Frame& F0, int l) {
    const Frame F = phase_frame(F0);
    int* pre = (int*)(F.lds + 131072);
    moe_prefix(F, l, pre);
    const int nexp = RFL(pre[NE]); const int* cnt = (const int*)(F.ws + CTL_CNT) + l * 256; const int* LIST = wsp<int>(F, WS_LIST); const float* WSLOT = wsp<float>(F, WS_WSLOT);
    const bf16_t* G = wsp<bf16_t>(F, WS_G); const bf16_t* GSH = wsp<bf16_t>(F, WS_GSH); bf16_t* Y = wsp<bf16_t>(F, WS_Y); bf16_t* YSH = wsp<bf16_t>(F, WS_YSH);
    const bf16_t* WE = wsp<bf16_t>(F, WS_WE2) + (size_t)l * NE * 1024 * 256; const bf16_t* WS = wsp<bf16_t>(F, WS_WSH2) + (size_t)l * 1024 * 256;
    const int xl = F.bid & 7, rk = F.bid >> 3, nr = F.G >> 3; const int q0 = RFL(pre[32 * xl]), nq = RFL(pre[32 * xl + 32]) - q0;
    const int ntot = nq * 4 + (l == 1 ? 8 : 9) * 4;
    gemm_stream(rk, nr, ntot,
        [&](int j) { if (j < nq * 4) { const int q = q0 + (j >> 2), ct = j & 3; const int ei = moe_find(pre, q); const int e = (ei & 31) * 8 + (ei >> 5);
                return g8::GU{G, WE + ((size_t)e * 1024 + ct * 256) * 256, q * 256, 0, 0}; }
            const int v = j - nq * 4, pan = label_panel(xl, v >> 2), ct = v & 3; return g8::GU{GSH, WS + (size_t)ct * 256 * 256, pan * 256, 0, 0}; },
        [&](int j, int jn, const g8::GU& cur, bool pf, bool hn, const g8::GU& nx) -> bool {
            if (j < nq * 4) { const int q = q0 + (j >> 2), ct = j & 3; const int ei = moe_find(pre, q); const int e = (ei & 31) * 8 + (ei >> 5); const int rb = q - RFL(pre[ei]);
                EpiScatterY E{Y + ct * 256, LIST + (size_t)e * T * 2, RFL(cnt[e]), rb * 256, T * 8 + F.bid};
                g8::gemm256<false, 0, true, 1, 16>(F.lds, cur, 256, 256, E, pf, hn, nx); }
            else { const int v = j - nq * 4, pan = label_panel(xl, v >> 2), ct = v & 3; EpiStoreBf16 E{YSH + (size_t)pan * 256 * 1024 + ct * 256, 1024};
                g8::gemm256<false, 0, true, 1, 16>(F.lds, cur, 256, 256, E, pf, hn, nx); } return hn; });
    __syncthreads();
}

#ifndef MK_DEBUG
#define MK_DEBUG 0
#endif
constexpr size_t CTL_DBG = CTL_CNT + 2 * 256 * 4;
__device__ __forceinline__ void dbg_checksum(const Frame& F0, size_t off, size_t nbytes, int slot) {
    const Frame F = phase_frame(F0);
    const unsigned* p = (const unsigned*)(F.ws + off); const size_t n = nbytes / 4;
    unsigned long long s = 0;
    for (size_t i = (size_t)F.bid * NTHR + F.tid; i < n; i += (size_t)F.G * NTHR) s += (unsigned long long)p[i] * (unsigned long long)((unsigned)i * 2654435761u + 12345u);
    for (int o = 32; o >= 1; o >>= 1) { const unsigned lo = shx((int)(unsigned)s, o, F.lane), hi = shx((int)(unsigned)(s >> 32), o, F.lane); s += ((unsigned long long)hi << 32) | lo; }
    if (F.lane == 0) atomicAdd((unsigned long long*)(F.ws + CTL_DBG) + slot, s);
}
constexpr int NPH = 26;
__global__ void __launch_bounds__(NTHR, 2) fwd(Args a) {
    extern __shared__ __attribute__((aligned(16))) unsigned char lds[];
    Frame F;
    F.x = a.in[I_X]; F.ctx = a.in[I_CTX]; F.ew1 = a.in[I_EW1]; F.ew3 = a.in[I_EW3]; F.ew2 = a.in[I_EW2]; F.out = a.out; F.ws = a.ws; F.lds = (char*)lds;
    F.tid = threadIdx.x; F.lane = F.tid & 63; F.wave = __builtin_amdgcn_readfirstlane(F.tid >> 6); F.G = gridDim.x; F.bid = blockIdx.x;
    const int lo = a.ph_lo, hi = a.ph_hi;
    volatile LAS unsigned* st = (volatile LAS unsigned*)(LAS unsigned char*)(lds + LDS_BYTES - 16);
    XcdBarrier bar; bar.bar = (unsigned*)(a.ws + WS_CTL); bar.x = 0; bar.st = st;
    if (hi - lo > 1) {
        if (F.tid == 0) { st[0] = 0u; st[1] = 0u; }
        __syncthreads();
        bar = xcd_barrier_post((unsigned*)(a.ws + WS_CTL), st);
    }
#ifndef PHMASK
#define PHMASK 0xfff
#endif
#define ON(j) ((PHMASK >> (j)) & 1)
#ifndef REPMASK
#define REPMASK 0
#endif
#define REP(j) ((REPMASK >> (j)) & 1)
#ifndef MK_POISON
#define MK_POISON 0
#endif
#define LDS_NAN() do { if (MK_POISON) { __syncthreads(); for (int _i = F.tid; _i < (LDS_BYTES - 16) / 4; _i += NTHR) ((unsigned*)lds)[_i] = 0xFFFFFFFFu; __syncthreads(); } } while (0)
#define IN(k) (lo <= (k) && (k) < hi)
#define SEAM(k) do { if (IN(k) && IN((k) + 1)) { xcd_barrier(bar); LDS_NAN(); } } while (0)
#if MK_DEBUG == 2
#define XCS(id, sums) do { xcd_barrier(bar); { const int _s = (id); sums } } while (0)
#else
#define XCS(id, sums) do { } while (0)
#endif
#define CS(off, bytes) dbg_checksum(F, off, bytes, _s);
#if MK_POISON
    { u32x4* w = (u32x4*)(a.ws + WS_MODV); const size_t n = (WS_END - WS_MODV) / 16; const u32x4 nanv = {0xFFFFFFFFu, 0xFFFFFFFFu, 0xFFFFFFFFu, 0xFFFFFFFFu};
      for (size_t i = (size_t)F.bid * NTHR + F.tid; i < n; i += (size_t)F.G * NTHR) w[i] = nanv;
      xcd_barrier(bar); LDS_NAN(); }
#endif
    if (ON(0) && IN(0)) { phase_prologue(F, a); if (REP(0)) { xcd_barrier(bar); phase_prologue(F, a); } }
    SEAM(0);
    XCS(1, CS(WS_MODV, (size_t)(WS_WE13 - WS_MODV)) CS(WS_WE13, (size_t)64 << 20) CS(WS_WE2, (size_t)64 << 20));
#if MK_DEBUG == 1
#define DBGRUN(id, call, sums) do { call; xcd_barrier(bar); { const int _s = 2 * (id); sums } xcd_barrier(bar); call; xcd_barrier(bar); { const int _s = 2 * (id) + 1; sums } xcd_barrier(bar); } while (0)
#else
#define DBGRUN(id, call, sums) do { call; } while (0)
#endif
#define LAYER(l) do { constexpr int pb = 1 + 12 * (l); \
        if (ON(1) && IN(pb + 0)) phase_norm1(F, l); \
        XCS(2 + 14 * (l), CS(WS_XL, (size_t)T * D * 4) CS(WS_H, (size_t)T * D * 2) CS(WS_GATE + (size_t)(l) * T * 16 * 4, (size_t)T * 16 * 4)); \
        SEAM(pb + 0); \
        if (ON(2) && IN(pb + 1)) DBGRUN(10 * (l) + 0, phase_gemm_in(F, l), CS(WS_U, USZ)); \
        if (REP(2)) { xcd_barrier(bar); phase_gemm_in(F, l); } \
        XCS(3 + 14 * (l), CS(WS_U, USZ)); \
        SEAM(pb + 1); \
        if (ON(4) && IN(pb + 3)) DBGRUN(10 * (l) + 2, phase_mixers(F, l), CS(WS_O, (size_t)T * D * 4) CS(WS_HF, (size_t)T * 256 * 4) CS(WS_HB, (size_t)T * 256 * 4) CS(WS_HYO, (size_t)T * 256 * 4)); \
        if (REP(4)) { xcd_barrier(bar); if (F.bid == 0 && F.tid == 0) __hip_atomic_store((unsigned*)(a.ws + CTL_WQ) + 64 * (l), 0u, __ATOMIC_RELAXED, __HIP_MEMORY_SCOPE_AGENT); xcd_barrier(bar); phase_mixers(F, l); } \
        XCS(5 + 14 * (l), CS(WS_O, (size_t)T * D * 4)); XCS(6 + 14 * (l), CS(WS_HF, (size_t)T * 256 * 4) CS(WS_HB, (size_t)T * 256 * 4)); XCS(7 + 14 * (l), CS(WS_HYO, (size_t)T * 256 * 4)); \
        if (MK_DEBUG == 3) { xcd_barrier(bar); { const int _s = 4 * (l); CS(WS_HF, (size_t)T * 256 * 4) CS(WS_HB, (size_t)T * 256 * 4) } xcd_barrier(bar); phase_mlstm_only(F, l); xcd_barrier(bar); { const int _s = 4 * (l) + 1; CS(WS_HF, (size_t)T * 256 * 4) CS(WS_HB, (size_t)T * 256 * 4) } } \
        SEAM(pb + 3); \
        if (ON(5) && IN(pb + 4)) DBGRUN(10 * (l) + 3, phase_finish(F, l), CS(WS_MIX, (size_t)T * D * 2)); \
        if (REP(5)) { xcd_barrier(bar); phase_finish(F, l); } \
        XCS(8 + 14 * (l), CS(WS_MIX, (size_t)T * D * 2)); \
        SEAM(pb + 4); \
        if (ON(6) && IN(pb + 5)) phase_gemm_out(F, a, l); \
        XCS(9 + 14 * (l), CS(WS_XL, (size_t)T * D * 4)); \
        SEAM(pb + 5); \
        if (ON(7) && IN(pb + 6)) phase_norm2(F, l); \
        SEAM(pb + 6); \
        if (ON(7) && IN(pb + 7)) phase_rgemm(F, l); \
        if (REP(7)) { xcd_barrier(bar); phase_rgemm(F, l); } \
        SEAM(pb + 7); \
        if (ON(7) && IN(pb + 8)) phase_topk(F, l); \
        XCS(10 + 14 * (l), CS(WS_EIDX, (size_t)T * 8 * 4) CS(WS_WSLOT, (size_t)T * 8 * 4)); \
        SEAM(pb + 8); \
        if (ON(7) && IN(pb + 9)) phase_lists(F, l); \
        if (REP(10)) { xcd_barrier(bar); phase_lists(F, l); } \
        XCS(11 + 14 * (l), CS(CTL_CNT, 2048)); \
        SEAM(pb + 9); \
        if (ON(8) && IN(pb + 10)) DBGRUN(10 * (l) + 4, phase_moe1(F, l), CS(WS_GSH, (size_t)T * 256 * 2)); \
        if (REP(8)) { xcd_barrier(bar); phase_moe1(F, l); } \
        XCS(12 + 14 * (l), CS(WS_GSH, (size_t)T * 256 * 2) CS(WS_G, (size_t)T * 8 * 256 * 2)); \
        SEAM(pb + 10); \
        if (ON(9) && IN(pb + 11)) DBGRUN(10 * (l) + 5, phase_moe2(F, l), CS(WS_Y, (size_t)T * 8 * D * 2) CS(WS_YSH, (size_t)T * D * 2)); \
        if (REP(9)) { xcd_barrier(bar); phase_moe2(F, l); } \
        XCS(13 + 14 * (l), CS(WS_Y, (size_t)T * 8 * D * 2) CS(WS_YSH, (size_t)T * D * 2)); \
        SEAM(pb + 11); } while (0)
    LAYER(0);
    LAYER(1);
#undef LAYER
    if (ON(10) && IN(25)) phase_norm1(F, 2);
#if MK_DEBUG == 2
    xcd_barrier(bar);
    { float ss = 0.f; for (size_t i = (size_t)F.bid * NTHR + F.tid; i < (size_t)NB * SEQ * D; i += (size_t)F.G * NTHR) ss += a.out[i] * a.out[i];
      ss = wsum(ss, F.lane); if (F.lane == 0) atomicAdd((float*)(a.ws + CTL_DBG + 63 * 8), ss); }
    xcd_barrier(bar);
    if (F.bid == 0 && F.tid == 0) { const unsigned long long* dbg = (const unsigned long long*)(a.ws + CTL_DBG); unsigned long long* prev = (unsigned long long*)(a.ws + WS_END);
        int bad = 0; const bool have = prev[63] == 0x600DF00D12345678ull; const unsigned long long nl = have ? prev[62] : 0ull;
        for (int i = 31; i >= 1; --i) { if (have && nl >= 2ull && prev[i] != dbg[i]) bad = i; prev[i] = dbg[i]; }
        prev[63] = 0x600DF00D12345678ull; prev[62] = nl + 1ull;
        if (bad) a.out[0] = 0.1f * (float)bad * sqrtf(*(const float*)(a.ws + CTL_DBG + 63 * 8)); }
#endif
#if MK_DEBUG == 3
    xcd_barrier(bar);
    if (F.bid == 0 && F.tid == 0) { const unsigned long long* dbg = (const unsigned long long*)(a.ws + CTL_DBG);
        if (dbg[0] != dbg[1]) a.out[0] = 1000.f; if (dbg[4] != dbg[5]) a.out[1] = 3000.f; }
#endif
#if MK_DEBUG == 1
    xcd_barrier(bar);
    if (F.bid == 0 && F.tid == 0) { const unsigned long long* dbg = (const unsigned long long*)(a.ws + CTL_DBG); int bad = 0;
        for (int i = 15; i >= 0; --i) if (dbg[2 * i] != dbg[2 * i + 1]) bad = i + 1;
        if (bad) a.out[0] = 1000.f * (float)bad; }
#endif
#undef IN
#undef SEAM
}

extern "C" void kernel_launch(void* const* d_in, const int* in_sizes, int n_in, void* d_out, int out_size, void* d_ws, size_t ws_size, hipStream_t stream) {
    static int grid = 0;
    if (grid == 0) {
        if (n_in != 33 || ws_size < WS_END) { fprintf(stderr, "kernel_launch: n_in %d (want 33), ws %zu (want >= %zu)\n", n_in, ws_size, (size_t)WS_END); grid = -1; return; }
        int dev = 0, cus = 0, per_cu = 0;
        if (hipGetDevice(&dev) != hipSuccess || hipDeviceGetAttribute(&cus, hipDeviceAttributeMultiprocessorCount, dev) != hipSuccess) { grid = -1; return; }
        if (hipFuncSetAttribute((const void*)fwd, hipFuncAttributeMaxDynamicSharedMemorySize, LDS_BYTES) != hipSuccess) { fprintf(stderr, "kernel_launch: hipFuncSetAttribute failed\n"); grid = -1; return; }
        if (hipOccupancyMaxActiveBlocksPerMultiprocessor(&per_cu, (const void*)fwd, NTHR, LDS_BYTES) != hipSuccess || per_cu < 1) fprintf(stderr, "kernel_launch: occupancy query says %d\n", per_cu);
        (void)hipGetLastError();
        grid = cus & ~7;
    }
    if (grid < 0) return;
    (void)hipMemsetAsync((char*)d_ws + WS_CTL, 0, CTL_BYTES, stream);
    Args a{};
    for (int i = 0; i < 33; ++i) a.in[i] = (const float*)d_in[i];
    a.out = (float*)d_out; a.ws = (unsigned char*)d_ws;
#if MK_PER_PHASE
    for (int k = 0; k < NPH; ++k) { a.ph_lo = k; a.ph_hi = k + 1; hipLaunchKernelGGL(fwd, dim3(grid), dim3(NTHR), LDS_BYTES, stream, a); }
#else
    a.ph_lo = 0; a.ph_hi = NPH; hipLaunchKernelGGL(fwd, dim3(grid), dim3(NTHR), LDS_BYTES, stream, a);
#endif
    const hipError_t le = hipPeekAtLastError();
    if (le != hipSuccess) fprintf(stderr, "kernel_launch: launch failed: %s\n", hipGetErrorName(le));
}
```

```cpp
#include <hip/hip_runtime.h>
#include <hip/hip_bf16.h>
#include <cstdint>
#include <cstdio>

#ifndef MK_PER_PHASE
#define MK_PER_PHASE 0
#endif

constexpr int D = 1024, NB = 8, SEQ = 2048, CTX = 256, TB = SEQ + CTX  , T = NB * TB  ;
constexpr int NPAN = T / 256;
constexpr int NU = 3328;
constexpr int U_DA = 1024, U_HY = 2560;
constexpr int INC = 3344;
constexpr int NE = 256, TOPK = 8, EFF = 256;
constexpr int NTHR = 512;
constexpr float EPS = 1e-6f;
constexpr int LDS_BYTES = 147456;

typedef unsigned short bf16_t;
typedef short bf16x8 __attribute__((ext_vector_type(8)));
typedef short s16x4 __attribute__((ext_vector_type(4)));
typedef float f32x4 __attribute__((ext_vector_type(4)));
typedef float f32x8 __attribute__((ext_vector_type(8)));
typedef float f32x16 __attribute__((ext_vector_type(16)));
typedef unsigned u32x4 __attribute__((ext_vector_type(4)));
typedef unsigned u32x2 __attribute__((ext_vector_type(2)));
typedef int i32x2 __attribute__((ext_vector_type(2)));
typedef int i32x4 __attribute__((ext_vector_type(4)));

constexpr size_t al256(size_t x) { return (x + 255) / 256 * 256; }
constexpr size_t WS_CTL   = 0;
constexpr size_t CTL_BAR_BYTES = 16384;
constexpr size_t CTL_CNT  = CTL_BAR_BYTES;
constexpr size_t CTL_WQ = CTL_BAR_BYTES + 2 * 256 * 4 + 64 * 8;
constexpr size_t CTL_BYTES = CTL_WQ + 8 * 256;
constexpr size_t WS_MODV  = al256(WS_CTL + CTL_BYTES);
constexpr size_t WS_WG    = al256(WS_MODV + 2 * 9 * 6144 * 4);
constexpr size_t WS_HYT   = al256(WS_WG + 2 * 16 * 1024 * 4);
constexpr size_t WS_PAR   = al256(WS_HYT + 2 * 2304 * 64 * 4);
constexpr int PAR_N1G = 0, PAR_N2G = 2048, PAR_MLGB = 4096, PAR_MLNG = 4128, PAR_DAQG = 4640, PAR_DAKG = 4768, PAR_DALAM = 4896, PAR_DASUB = 5408, PAR_HYCW = 5664, PAR_HYCB = 10272,
              PAR_HYSKIP = 11808, PAR_RB = 12832, PAR_HYW3 = 13344, PAR_RW = 144416, PAR_ROPER = 668704  , PAR_ROPEC = 669728  , PAR_END = 671776;
constexpr size_t WS_KF    = al256(WS_PAR + (size_t)PAR_END * 4);
constexpr size_t WS_WIN   = al256(WS_KF + (size_t)2 * 2 * 256 * 4096 * 4);
constexpr size_t WS_WOUT  = al256(WS_WIN + (size_t)2 * NU * D * 2);
constexpr size_t WS_WSH13 = al256(WS_WOUT + (size_t)2 * D * D * 2);
constexpr size_t WS_WSH2  = al256(WS_WSH13 + (size_t)2 * 512 * D * 2);
constexpr size_t WS_WE13  = al256(WS_WSH2 + (size_t)2 * D * 256 * 2);
constexpr size_t WS_WE2   = al256(WS_WE13 + (size_t)2 * NE * 512 * D * 2);
constexpr size_t WS_XL    = al256(WS_WE2 + (size_t)2 * NE * D * 256 * 2);
constexpr size_t WS_H     = al256(WS_XL + (size_t)T * D * 4);
constexpr size_t WS_GATE  = al256(WS_H + (size_t)T * D * 2);
constexpr size_t WS_WSLOT = al256(WS_GATE + (size_t)2 * T * 16 * 4);
constexpr size_t WS_EIDX  = al256(WS_WSLOT + (size_t)T * 8 * 4);
constexpr size_t WS_H2X   = al256(WS_EIDX + (size_t)T * 8 * 4);
constexpr size_t WS_LOG   = al256(WS_H2X + (size_t)T * 2048 * 2);
constexpr size_t WS_WR    = al256(WS_LOG + (size_t)T * 256 * 4);
constexpr size_t WS_ALIAS = al256(WS_WR + (size_t)2 * 256 * 3072 * 2);
constexpr size_t WS_U     = WS_ALIAS;
constexpr size_t USZ = (size_t)T * NU * 2;
constexpr size_t WS_QN    = al256(WS_U + USZ);
constexpr size_t WS_KN    = al256(WS_QN + (size_t)NB * 8 * TB * 64 * 2);
constexpr size_t WS_O     = al256(WS_KN + (size_t)NB * 8 * TB * 64 * 2);
constexpr size_t WS_HF    = al256(WS_O + (size_t)T * D * 4);
constexpr size_t WS_HB    = al256(WS_HF + (size_t)T * 256 * 4);
constexpr size_t WS_MIX   = al256(WS_HB + (size_t)T * 256 * 4);
constexpr size_t WS_HYO   = al256(WS_MIX + (size_t)T * D * 2);
constexpr size_t WS_UH    = al256(WS_HYO + (size_t)T * 256 * 4);
constexpr size_t WS_A_END = al256(WS_UH + (size_t)768 * T * 2);
constexpr int GROWS = T * TOPK + NE * 256;
constexpr size_t WS_G     = WS_ALIAS;
constexpr size_t WS_Y     = al256(WS_G + (size_t)GROWS * 256 * 2);
constexpr size_t WS_YSH   = al256(WS_Y + (size_t)(T * 8 + 256) * D * 2);
constexpr size_t WS_GSH   = al256(WS_YSH + (size_t)T * D * 2);
constexpr size_t WS_LIST  = al256(WS_GSH + (size_t)T * 256 * 2);
constexpr size_t WS_HIST  = al256(WS_LIST + (size_t)NE * T * 8);
constexpr size_t WS_B_END = al256(WS_HIST + (size_t)512 * NE * 4);
constexpr size_t WS_END   = WS_A_END > WS_B_END ? WS_A_END : WS_B_END;

__device__ __forceinline__ bf16_t f2bf(float x) { unsigned u = __float_as_uint(x); u += 0x7fffu + ((u >> 16) & 1u); return (bf16_t)(u >> 16); }
__device__ __forceinline__ float bf2f(bf16_t h) { return __uint_as_float(((unsigned)h) << 16); }
__device__ __forceinline__ unsigned cvtpk(float lo, float hi) { unsigned r; asm volatile("v_cvt_pk_bf16_f32 %0, %1, %2" : "=v"(r) : "v"(lo), "v"(hi)); return r; }
__device__ __forceinline__ float shx(float v, int off, int lane) { return __int_as_float(__builtin_amdgcn_ds_bpermute((lane ^ off) << 2, __float_as_int(v))); }
__device__ __forceinline__ int shx(int v, int off, int lane) { return __builtin_amdgcn_ds_bpermute((lane ^ off) << 2, v); }
__device__ __forceinline__ float shi(float v, int src) { return __int_as_float(__builtin_amdgcn_ds_bpermute(src << 2, __float_as_int(v))); }
__device__ __forceinline__ float shup(float v, int o, int lane) { return __int_as_float(__builtin_amdgcn_ds_bpermute((lane - o) << 2, __float_as_int(v))); }
template <int CTRL> __device__ __forceinline__ float dpp_f(float v) { return __int_as_float(__builtin_amdgcn_update_dpp(0, __float_as_int(v), CTRL, 0xf, 0xf, false)); }
__device__ __forceinline__ float rowsum16(float v) { v += dpp_f<0x128>(v); v += dpp_f<0x124>(v); v += dpp_f<0x122>(v); v += dpp_f<0x121>(v); return v; }
__device__ __forceinline__ float sum8(float v) { v += dpp_f<0xB1>(v); v += dpp_f<0x4E>(v); v += dpp_f<0x141>(v); return v; }
__device__ __forceinline__ float fexp(float x) { return __builtin_amdgcn_exp2f(x * 1.4426950408889634f); }
__device__ __forceinline__ float wsum(float v, int lane) { for (int o = 32; o >= 1; o >>= 1) v += shx(v, o, lane); return v; }
__device__ __forceinline__ float sigmoidf_(float x) { return 1.f / (1.f + __expf(-x)); }
__device__ __forceinline__ float siluf_(float x) { return x * __builtin_amdgcn_rcpf(1.f + __expf(-x)); }

#define XB_TMO      128
#define XB_XCNT(j)  (256  + 64 * (j))
#define XB_XSUB(j)  (1280 + 64 * (j))
#define XB_XGEN(j)  (2304 + 64 * (j))
#define XB_TOP      3328
#define XB_TOPGEN   3392
#define XCD_BAR_WORDS 3456
#define XB_SPIN_CAP (1u << 18)
#define LAS __attribute__((address_space(3)))
__device__ __forceinline__ unsigned xb_ld(unsigned* p)              { return __hip_atomic_load(p, __ATOMIC_RELAXED, __HIP_MEMORY_SCOPE_AGENT); }
__device__ __forceinline__ unsigned xb_add(unsigned* p, unsigned v) { return __hip_atomic_fetch_add(p, v, __ATOMIC_RELAXED, __HIP_MEMORY_SCOPE_AGENT); }
__device__ __forceinline__ unsigned xb_xcc_id() { return (unsigned)__builtin_amdgcn_s_getreg((3 << 11) | 20) & 0xFu; }
#define XB_SPIN(cond, bar) do { unsigned _sp = 0; while (cond) { __builtin_amdgcn_s_sleep(1); \
    if ((++_sp & 255u) == 0u) { if (xb_ld(&(bar)[XB_TMO])) break; if (_sp > XB_SPIN_CAP) { atomicAdd(&(bar)[XB_TMO], 1u); break; } } } } while (0)
struct XcdBarrier { unsigned* bar; unsigned x; volatile LAS unsigned* st; };
__device__ __forceinline__ XcdBarrier xcd_barrier_post(unsigned* bar, volatile LAS unsigned* st) {
    XcdBarrier b; b.bar = bar; b.x = xb_xcc_id(); b.st = st;
    if (threadIdx.x == 0) (void)xb_add(&bar[XB_XCNT(b.x)], 1u);
    return b;
}
__device__ __forceinline__ void xcd_barrier_complete(unsigned* bar, unsigned x, unsigned& nloc, unsigned& nx) {
    const unsigned G = gridDim.x * gridDim.y * gridDim.z;
    unsigned sum, cnt, mine, sp = 0u;
    for (;;) {
        sum = 0u; cnt = 0u; mine = 0u;
#pragma unroll
        for (unsigned j = 0; j < 16; ++j) { const unsigned c = xb_ld(&bar[XB_XCNT(j)]); sum += c; cnt += (c > 0u) ? 1u : 0u; mine = (j == x) ? c : mine; }
        if (sum == G) break;
        __builtin_amdgcn_s_sleep(1);
        if ((++sp & 255u) == 0u) { if (xb_ld(&bar[XB_TMO])) break; if (sp > XB_SPIN_CAP) { atomicAdd(&bar[XB_TMO], 1u); break; } }
    }
    nloc = mine > 0u ? mine : 1u; nx = cnt > 0u ? cnt : 1u;
}
__device__ __forceinline__ void xcd_barrier(const XcdBarrier& b) {
    asm volatile("s_waitcnt vmcnt(0)" ::: "memory");
    __syncthreads();
    if (threadIdx.x == 0) {
        unsigned* bar = b.bar;
        __builtin_amdgcn_s_waitcnt(0);
        unsigned nloc = b.st[0], nx = b.st[1];
        if (nloc == 0u) { xcd_barrier_complete(bar, b.x, nloc, nx); b.st[0] = nloc; b.st[1] = nx; }
        const unsigned old = xb_add(&bar[XB_XSUB(b.x)], 1u);
        const unsigned gen = old / nloc;
        if (old + 1u == (gen + 1u) * nloc) {
            __builtin_amdgcn_fence(__ATOMIC_RELEASE, "agent");
            asm volatile("s_waitcnt vmcnt(0)" ::: "memory");
            const unsigned og = xb_add(&bar[XB_TOP], 1u);
            const unsigned tg = og / nx;
            if (og + 1u == (tg + 1u) * nx) xb_add(&bar[XB_TOPGEN], 1u);
            else XB_SPIN(xb_ld(&bar[XB_TOPGEN]) == tg, bar);
            __builtin_amdgcn_fence(__ATOMIC_ACQUIRE, "agent");
            xb_add(&bar[XB_XGEN(b.x)], 1u);
            asm volatile("s_waitcnt vmcnt(0)" ::: "memory");
        } else {
            XB_SPIN(xb_ld(&bar[XB_XGEN(b.x)]) == gen, bar);
            __builtin_amdgcn_fence(__ATOMIC_ACQUIRE, "agent");
            asm volatile("s_waitcnt vmcnt(0)" ::: "memory");
        }
    }
    __syncthreads();
}

struct Args { const float* in[33]; float* out; unsigned char* ws; int ph_lo, ph_hi; };
struct Frame {
    const float* x; const float* ctx; const float* ew1; const float* ew3; const float* ew2; float* out; unsigned char* ws; char* lds;
    int tid, lane, wave, G, bid;
};
enum { I_X = 0, I_C, I_CTX, I_CCTX, I_WMOD, I_BMOD, I_N1G, I_N2G, I_WIN, I_MLGB, I_MLNG, I_DAQG, I_DAKG, I_DALAM, I_DASUB, I_HYCW, I_HYCB,
       I_HYW1, I_HYB1, I_HYW2, I_HYB2, I_HYW3, I_HYFREQ, I_HYSKIP, I_WOUT, I_RW, I_RB, I_EW1, I_EW3, I_EW2, I_SW1, I_SW3, I_SW2 };
template <class Tp> __device__ __forceinline__ Tp* wsp(const Frame& F, size_t off) { return (Tp*)(F.ws + off); }
__device__ __forceinline__ const float* par(const Frame& F, int off) { return (const float*)(F.ws + WS_PAR) + off; }
__device__ __forceinline__ Frame phase_frame(const Frame& F0) { Frame F = F0; int t = threadIdx.x; asm volatile("" : "+v"(t)); F.tid = t; F.lane = t & 63; F.wave = __builtin_amdgcn_readfirstlane(t >> 6);
    __attribute__((address_space(1))) unsigned char* w = (__attribute__((address_space(1))) unsigned char*)F0.ws; asm volatile("" : "+s"(w)); F.ws = (unsigned char*)w;
    unsigned lb = (unsigned)(uintptr_t)(LAS char*)F0.lds; asm volatile("" : "+s"(lb)); F.lds = (char*)(LAS char*)(uintptr_t)lb; return F; }

namespace g8 {
constexpr int BM = 256, BK = 64, HALF = 128, HT = HALF * BK;
__device__ __forceinline__ int lds_byte(int r, int c) { int st = (r >> 4) * 2 + (c >> 5), rr = r & 15, cc = c & 31, ob = rr * 64 + cc * 2; return st * 1024 + (ob ^ (((ob >> 9) & 1) << 5)); }
__device__ __forceinline__ void stage_rc(int b, int& R, int& C) { int st = b / 1024, sb = b % 1024, swz = sb ^ (((sb >> 9) & 1) << 5); R = (st >> 1) * 16 + swz / 64; C = (st & 1) * 32 + (swz % 64) / 2; }
__device__ __forceinline__ int perm32(int rho) { const int n = rho >> 4, i = rho & 15; return 8 * (i >> 2) + 4 * n + (i & 3); }
__device__ __forceinline__ int stage_row(int t, int i) { int R, C; stage_rc(t * 16 + i * 8192, R, C); return R; }

struct GU { const bf16_t* A; const bf16_t* Bt; int arow0, pk0, pk1; };
template <int N> __device__ __forceinline__ void wait_v() { asm volatile("s_waitcnt vmcnt(%0)" :: "n"(N) : "memory"); }
template <bool GATHER, int AWRAP = 0, bool TR = true, int NCT = 1, int PST = 0, class Epi>
__device__ __forceinline__ void gemm256(char* shmc, const GU& cur, const int lda, const int K, const Epi& epi, const bool prefetched, const bool has_next, const GU& nxt) {
    bf16_t* shm = (bf16_t*)shmc;
#define SA(b,h) (shm+((b)*2+(h))*HT)
#define SB(b,h) (shm+(4+(b)*2+(h))*HT)
#define STAGE_A(T,P,h,kt,U_) do{ int _pk = (h) ? U_.pk1 : U_.pk0; if (GATHER) asm volatile("" : "+v"(_pk));     \
    for(int _i=0;_i<2;++_i){int _b=(T)*16+_i*8192;int _r,_c;stage_rc(_b,_r,_c); \
      const long _ro = GATHER ? (long)(_i ? (_pk >> 16) : (_pk & 0xffff))*lda : (long)(U_.arow0+(h)*HALF+_r)*lda; \
      const int _ka = NCT > 1 ? ((kt) & (ntk - 1)) : ((AWRAP && (kt) >= AWRAP) ? (kt) - AWRAP : (kt)); \
      __builtin_amdgcn_global_load_lds((const unsigned*)(U_.A+_ro+(long)_ka*BK+_c),(unsigned*)((char*)(P)+_b),16,0,0);}}while(0)
#define STAGE_B(T,P,h,kt,U_) do{ for(int _i=0;_i<2;++_i){int _b=(T)*16+_i*8192;int _r,_c;stage_rc(_b,_r,_c); \
      const long _kb = NCT > 1 ? (long)((kt) / ntk) * 256 * K + (long)((kt) & (ntk - 1)) * BK : (long)(kt) * BK; \
      const int _rs = TR ? ((_r & ~31) | perm32(_r & 31)) : _r; \
      __builtin_amdgcn_global_load_lds((const unsigned*)(U_.Bt+(long)((h)*HALF+_rs)*K+_kb+_c),(unsigned*)((char*)(P)+_b),16,0,0);}}while(0)
#define STAGE_FIRST2(T,U_) do{ STAGE_B(T, SB(0,0), 0, 0, U_); SCHED; STAGE_A(T, SA(0,0), 0, 0, U_); SCHED; STAGE_B(T, SB(0,1), 1, 0, U_); SCHED; STAGE_A(T, SA(0,1), 1, 0, U_); SCHED; \
      STAGE_B(T, SB(1,0), 0, 1, U_); SCHED; STAGE_A(T, SA(1,0), 0, 1, U_); SCHED; STAGE_B(T, SB(1,1), 1, 1, U_); SCHED; }while(0)
#define STAGE_T0(T,U_) do{ STAGE_B(T, SB(0,0), 0, 0, U_); SCHED; STAGE_A(T, SA(0,0), 0, 0, U_); SCHED; STAGE_B(T, SB(0,1), 1, 0, U_); SCHED; STAGE_A(T, SA(0,1), 1, 0, U_); SCHED; }while(0)
#define STAGE_T1(T,U_) do{ STAGE_B(T, SB(1,0), 0, 1, U_); SCHED; STAGE_A(T, SA(1,0), 0, 1, U_); SCHED; STAGE_B(T, SB(1,1), 1, 1, U_); SCHED; }while(0)
#define LDA(dst,b,h) for(int m=0;m<4;++m)for(int k=0;k<2;++k) \
    dst[m][k]=*reinterpret_cast<const bf16x8*>((char*)SA(b,h)+lds_byte(wr*64+m*16+fr,k*32+fq*8))
#define LDB(dst,b,h) for(int n=0;n<2;++n)for(int k=0;k<2;++k) \
    dst[n][k]=*reinterpret_cast<const bf16x8*>((char*)SB(b,h)+lds_byte(wc*32+n*16+fr,k*32+fq*8))
#define MMA(ai,bj,At,Bq) do{__builtin_amdgcn_s_setprio(1); \
    for(int m=0;m<4;++m)for(int n=0;n<2;++n)for(int k=0;k<2;++k) \
      acc[ai][bj][m][n]=TR ? __builtin_amdgcn_mfma_f32_16x16x32_bf16(Bq[n][k],At[m][k],acc[ai][bj][m][n],0,0,0) : __builtin_amdgcn_mfma_f32_16x16x32_bf16(At[m][k],Bq[n][k],acc[ai][bj][m][n],0,0,0); \
    __builtin_amdgcn_s_setprio(0);}while(0)
#define WAIT_V(n) asm volatile("s_waitcnt vmcnt(" #n ")":::"memory")
#define WAIT_L(n) asm volatile("s_waitcnt lgkmcnt(" #n ")":::"memory")
#define BAR __builtin_amdgcn_s_barrier()
#define SCHED __builtin_amdgcn_sched_barrier(0)
    int tx = threadIdx.x; asm volatile("" : "+v"(tx));
    int wid = tx >> 6, lane = tx & 63, wr = wid >> 2, wc = wid & 3, fr = lane & 15, fq = lane >> 4;
    f32x4 acc[2][2][4][2] = {};
    bf16x8 At[4][2], B0[2][2], B1[2][2];
    const int ntk = K / BK, nt = NCT * ntk;
    if (!prefetched) { STAGE_FIRST2(tx, cur); WAIT_V(0); } else wait_v<PST + 6>();
    if (wr == 1) BAR;
    BAR;
#pragma unroll 1
    for (int t = 0; t < nt - 2; t += 2) {
        LDB(B0,0,0); SCHED; LDA(At,0,0); STAGE_A(tx, SA(1,1), 1, t+1, cur);
        WAIT_L(8); BAR; WAIT_L(0); MMA(0,0,At,B0); BAR; SCHED;
        LDB(B1,0,1); STAGE_B(tx, SB(0,0), 0, t+2, cur);
        BAR; WAIT_L(0); MMA(0,1,At,B1); BAR;
        LDA(At,0,1); STAGE_A(tx, SA(0,0), 0, t+2, cur);
        BAR; WAIT_L(0); MMA(1,0,At,B0); BAR; SCHED;
        STAGE_B(tx, SB(0,1), 1, t+2, cur);
        WAIT_V(6); BAR; MMA(1,1,At,B1); BAR;
        LDB(B0,1,0); SCHED; LDA(At,1,0); STAGE_A(tx, SA(0,1), 1, t+2, cur);
        WAIT_L(8); BAR; WAIT_L(0); MMA(0,0,At,B0); BAR; SCHED;
        LDB(B1,1,1); STAGE_B(tx, SB(1,0), 0, t+3, cur);
        BAR; WAIT_L(0); MMA(0,1,At,B1); BAR;
        LDA(At,1,1); STAGE_A(tx, SA(1,0), 0, t+3, cur);
        BAR; WAIT_L(0); MMA(1,0,At,B0); BAR; SCHED;
        STAGE_B(tx, SB(1,1), 1, t+3, cur);
        WAIT_V(6); BAR; MMA(1,1,At,B1); BAR;
        if (NCT > 1 && ((t + 2) & (ntk - 1)) == 0) {
            epi(acc, wr, wc, fr, fq, t / ntk, epi.pre(wr, wc, fr, fq));
#pragma unroll
            for (int i0 = 0; i0 < 2; ++i0)
#pragma unroll
            for (int i1 = 0; i1 < 2; ++i1)
#pragma unroll
            for (int i2 = 0; i2 < 4; ++i2)
#pragma unroll
            for (int i3 = 0; i3 < 2; ++i3) acc[i0][i1][i2][i3] = (f32x4){0.f, 0.f, 0.f, 0.f}; }
    }
    int tz = threadIdx.x; asm volatile("" : "+v"(tz)); wid = tz >> 6; lane = tz & 63; wr = wid >> 2; wc = wid & 3; fr = lane & 15; fq = lane >> 4;
    { LDB(B0,0,0); LDA(At,0,0); STAGE_A(tz, SA(1,1), 1, nt-1, cur);
      BAR; WAIT_L(0); MMA(0,0,At,B0); BAR;
      LDB(B1,0,1); BAR; WAIT_L(0); MMA(0,1,At,B1); BAR;
      LDA(At,0,1); WAIT_V(4); BAR; WAIT_L(0); MMA(1,0,At,B0); MMA(1,1,At,B1); BAR; }
    { LDB(B0,1,0); LDA(At,1,0); WAIT_V(2); BAR; WAIT_L(0); MMA(0,0,At,B0);
      if (has_next) { int tn = threadIdx.x; asm volatile("" : "+v"(tn)); STAGE_T0(tn, nxt); }
      BAR;
      LDB(B1,1,1); if (has_next) WAIT_V(8); else WAIT_V(0); BAR; WAIT_L(0); MMA(0,1,At,B1); BAR;
      LDA(At,1,1); BAR; WAIT_L(0); MMA(1,0,At,B0); MMA(1,1,At,B1); BAR; }
    if (wr == 0) BAR;
    typename Epi::Pre epre = epi.pre(wr, wc, fr, fq); epi.land(epre);
    if (has_next) { int tn = threadIdx.x; asm volatile("" : "+v"(tn)); STAGE_T1(tn, nxt); }
    epi(acc, wr, wc, fr, fq, NCT - 1, epre);
#undef SA
#undef SB
#undef STAGE_A
#undef STAGE_B
#undef STAGE_FIRST2
#undef STAGE_T0
#undef STAGE_T1
#undef LDA
#undef LDB
#undef MMA
}
}

namespace att {
using bf16 = __hip_bfloat16;
constexpr int DH = 128, NW = 8, QBLK = 32, KVBLK = 64;
constexpr float SCALE = 0.125f;
constexpr float THR = 8.f;
constexpr int SDEPTH = 2;
constexpr size_t SHM_V = KVBLK * DH * 2, SHM_K = KVBLK * DH * 2, SHM_ATTN = 2 * SHM_V + 2 * SHM_K + NW * 64 * 4;
#define KSWZ(row, colB) ((row) * 256 + ((colB) ^ (((row) & 7) << 4)))
#define SBAR() __builtin_amdgcn_sched_barrier(0)
__device__ __forceinline__ int crow(int r, int hi) { return (r & 3) + 8 * (r >> 2) + 4 * hi; }
__device__ __forceinline__ void partialSM(f32x16& p0, f32x16& p1, float& m_reg, float& mn, float& alpha) {
  constexpr float C = SCALE * 1.4426950408889634f;
  float pmax = p0[0]; for (int r = 1; r < 16; ++r) pmax = fmaxf(pmax, p0[r]); for (int r = 0; r < 16; ++r) pmax = fmaxf(pmax, p1[r]);
  { auto rr = __builtin_amdgcn_permlane32_swap(__float_as_uint(pmax), __float_as_uint(pmax), false, false);
    pmax = fmaxf(__uint_as_float(rr[0]), __uint_as_float(rr[1])); }
  if (__builtin_expect(__all(pmax - m_reg <= THR / SCALE), 1)) { mn = m_reg; alpha = 1.f; }
  else { mn = fmaxf(m_reg, pmax); alpha = __builtin_amdgcn_exp2f((m_reg - mn) * C); m_reg = mn; }
  float mnC = -mn * C;
  for (int r = 0; r < 16; ++r) p0[r] = fmaf(p0[r], C, mnC); for (int r = 0; r < 16; ++r) p1[r] = fmaf(p1[r], C, mnC);
  for (int r = 0; r < 16; ++r) p0[r] = __builtin_amdgcn_exp2f(p0[r]);
}
__device__ __forceinline__ void finishSM(f32x16& p0, f32x16& p1, float alpha, float& l_reg, bf16x8& pa0, bf16x8& pa1, bf16x8& pa2, bf16x8& pa3) {
  for (int r = 0; r < 16; ++r) p1[r] = __builtin_amdgcn_exp2f(p1[r]);
  float ps = 0; for (int r = 0; r < 16; ++r) ps += p0[r]; for (int r = 0; r < 16; ++r) ps += p1[r];
  { auto rr = __builtin_amdgcn_permlane32_swap(__float_as_uint(ps), __float_as_uint(ps), false, false);
    ps = __uint_as_float(rr[0]) + __uint_as_float(rr[1]); }
  l_reg = l_reg * alpha + ps;
#define PK4(P, BASE, OUT) do { unsigned a0 = cvtpk(P[BASE + 0], P[BASE + 1]), a1 = cvtpk(P[BASE + 2], P[BASE + 3]);   \
    unsigned b0 = cvtpk(P[BASE + 4], P[BASE + 5]), b1 = cvtpk(P[BASE + 6], P[BASE + 7]);                              \
    auto r0 = __builtin_amdgcn_permlane32_swap(a0, b0, false, false); auto r1 = __builtin_amdgcn_permlane32_swap(a1, b1, false, false); \
    u32x4 w = {r0[0], r1[0], r0[1], r1[1]}; OUT = *reinterpret_cast<bf16x8*>(&w); } while (0)
  PK4(p0, 0, pa0); PK4(p0, 8, pa1); PK4(p1, 0, pa2); PK4(p1, 8, pa3);
#undef PK4
}
__device__ __forceinline__ void qkt(f32x16& p0, f32x16& p1, const bf16* Ks, const bf16x8* qr, int r32, int hi) {
  p0 = f32x16{}; p1 = f32x16{};
  for (int d0 = 0; d0 < 8; ++d0) { int cb = (d0 * 16 + hi * 8) * 2;
    bf16x8 b0 = *reinterpret_cast<const bf16x8*>((const char*)Ks + KSWZ(r32, cb));
    bf16x8 b1 = *reinterpret_cast<const bf16x8*>((const char*)Ks + KSWZ(32 + r32, cb));
    p0 = __builtin_amdgcn_mfma_f32_32x32x16_bf16(b0, qr[d0], p0, 0, 0, 0);
    p1 = __builtin_amdgcn_mfma_f32_32x32x16_bf16(b1, qr[d0], p1, 0, 0, 0); }
}
__device__ __forceinline__ int v_st(int k, int c) { const int kk = (k & ~0xC) | ((k & 4) << 1) | ((k & 8) >> 1); return ((kk >> 3) * 4 + (c >> 5)) * 512 + ((kk & 7) * 32 + (c & 31)) * 2; }
__device__ __forceinline__ int v_rd_base(int lane) { return ((lane & 3) << 3) | (((lane >> 2) & 3) << 6) | (((lane >> 4) & 1) << 5) | (((lane >> 5) & 1) << 8); }
constexpr int v_rd_off(int d0, int ks, int half) { return d0 * 512 + ks * 4096 + half * 2048; }
template <int OFF> __device__ __forceinline__ s16x4 tr_read(int vb) {
  s16x4 r; asm volatile("ds_read_b64_tr_b16 %0, %1 offset:%2" : "=&v"(r) : "v"(vb), "i"(OFF) : "memory"); return r;
}
template <int D0> __device__ __forceinline__ void pv_one(f32x16& od, int vb, bf16x8 pa0, bf16x8 pa1, bf16x8 pa2, bf16x8 pa3) {
  const s16x4 l0 = tr_read<v_rd_off(D0, 0, 0)>(vb), h0 = tr_read<v_rd_off(D0, 0, 1)>(vb), l1 = tr_read<v_rd_off(D0, 1, 0)>(vb), h1 = tr_read<v_rd_off(D0, 1, 1)>(vb);
  const s16x4 l2 = tr_read<v_rd_off(D0, 2, 0)>(vb), h2 = tr_read<v_rd_off(D0, 2, 1)>(vb), l3 = tr_read<v_rd_off(D0, 3, 0)>(vb), h3 = tr_read<v_rd_off(D0, 3, 1)>(vb);
  asm volatile("s_waitcnt lgkmcnt(0)" ::: "memory"); SBAR();
#define PK(L, H) (bf16x8){L[0], L[1], L[2], L[3], H[0], H[1], H[2], H[3]}
  od = __builtin_amdgcn_mfma_f32_32x32x16_bf16(pa0, PK(l0, h0), od, 0, 0, 0);
  od = __builtin_amdgcn_mfma_f32_32x32x16_bf16(pa1, PK(l1, h1), od, 0, 0, 0);
  od = __builtin_amdgcn_mfma_f32_32x32x16_bf16(pa2, PK(l2, h2), od, 0, 0, 0);
  od = __builtin_amdgcn_mfma_f32_32x32x16_bf16(pa3, PK(l3, h3), od, 0, 0, 0);
#undef PK
}
__device__ __forceinline__ void pv_d0(f32x16* o, int vb, bf16x8 pa0, bf16x8 pa1, bf16x8 pa2, bf16x8 pa3) {
  pv_one<0>(o[0], vb, pa0, pa1, pa2, pa3); pv_one<1>(o[1], vb, pa0, pa1, pa2, pa3); pv_one<2>(o[2], vb, pa0, pa1, pa2, pa3); pv_one<3>(o[3], vb, pa0, pa1, pa2, pa3);
}
template <int LDQ, int LDK, int LDV, int LDO>
__device__ __forceinline__ void attn_dense_body(const bf16* __restrict__ Qb, const bf16* __restrict__ Kh, const bf16* __restrict__ Vh,
                                                float* __restrict__ Ob, int seq, char* lds) {
  int tid = threadIdx.x; asm volatile("" : "+v"(tid));
  const int wid = tid >> 6, lane = tid & 63, r32 = lane & 31, hi = lane >> 5;
  bf16* V_lds = (bf16*)lds; bf16* K_lds = (bf16*)(lds + 2 * SHM_V);
  float* ws = (float*)(lds + 2 * SHM_V + 2 * SHM_K) + wid * 64; float* li_l = ws; float* al_l = ws + 32;
  float m_reg = -1e30f, l_reg = 0; f32x16 o[4] = {}; bf16x8 qr[8];
  const bf16* Qw = Qb + (long)(wid * QBLK + r32) * LDQ + hi * 8;
#pragma unroll
  for (int d0 = 0; d0 < 8; ++d0) qr[d0] = *reinterpret_cast<const bf16x8*>(Qw + d0 * 16);
  const int sr = tid >> 4, sc = (tid & 15) * 8, vst0 = v_st(sr, sc), vst1 = v_st(32 + sr, sc);
  const int vb0 = (int)(uintptr_t)V_lds + v_rd_base(lane);
  const bf16* Vw = Vh + sr * LDV + sc; const bf16* Kw = Kh + sr * LDK + sc;
  struct { bf16x8 vs0, vs1, ks0, ks1; } sr_[SDEPTH];
#define SLOAD(i, k0) do { sr_[i].vs0 = *reinterpret_cast<const bf16x8*>(Vw + (k0) * LDV); sr_[i].vs1 = *reinterpret_cast<const bf16x8*>(Vw + ((k0) + 32) * LDV); \
    sr_[i].ks0 = *reinterpret_cast<const bf16x8*>(Kw + (k0) * LDK); sr_[i].ks1 = *reinterpret_cast<const bf16x8*>(Kw + ((k0) + 32) * LDK); } while (0)
#define SWRITE(b, i) do { *(bf16x8*)((char*)V_lds + (b) * SHM_V + vst0) = sr_[i].vs0;          \
    *(bf16x8*)((char*)V_lds + (b) * SHM_V + vst1) = sr_[i].vs1; int kc = sc * 2;               \
    *(bf16x8*)((char*)K_lds + (b) * SHM_K + KSWZ(sr, kc)) = sr_[i].ks0;                       \
    *(bf16x8*)((char*)K_lds + (b) * SHM_K + KSWZ(32 + sr, kc)) = sr_[i].ks1; } while (0)
#define SWAIT() do { asm volatile("s_waitcnt vmcnt(4)" ::: "memory"); } while (0)
#define RESC(a) do { if (__any((a) < 1.f)) { if (hi == 0) al_l[r32] = (a); asm volatile("s_waitcnt lgkmcnt(0)" ::: "memory"); \
    for (int d = 0; d < 4; ++d) for (int r = 0; r < 16; ++r) o[d][r] *= al_l[crow(r, hi)]; } } while (0)
  f32x16 pA0, pA1, pB0, pB1; float mnA, mnB, alA, alB; bf16x8 pa0, pa1, pa2, pa3; const int NT = seq / KVBLK;
  constexpr int SE = 0, SO = SDEPTH - 1;
  SLOAD(SE, 0); asm volatile("s_waitcnt vmcnt(0)" ::: "memory"); SWRITE(0, SE); __syncthreads();
  qkt(pA0, pA1, K_lds, qr, r32, hi); partialSM(pA0, pA1, m_reg, mnA, alA);
  SLOAD(SO, KVBLK); if (2 < NT) SLOAD(SE, 2 * KVBLK);
  SWAIT(); SWRITE(1, SO); __syncthreads();
  for (int j = 1; j + 1 < NT; j += 2) {
    SBAR(); qkt(pB0, pB1, (bf16*)((char*)K_lds + SHM_K), qr, r32, hi);
    finishSM(pA0, pA1, alA, l_reg, pa0, pa1, pa2, pa3); SBAR();
    SLOAD(SO, (j + SDEPTH) * KVBLK); SBAR();
    pv_d0(o, vb0, pa0, pa1, pa2, pa3); partialSM(pB0, pB1, m_reg, mnB, alB);
    __syncthreads(); SWAIT(); SWRITE(0, SE);
    RESC(alB); __syncthreads();
    SBAR(); qkt(pA0, pA1, K_lds, qr, r32, hi);
    finishSM(pB0, pB1, alB, l_reg, pa0, pa1, pa2, pa3); SBAR();
    if (j + 3 < NT) SLOAD(SE, (j + 1 + SDEPTH) * KVBLK); SBAR();
    pv_d0(o, vb0 + (int)SHM_V, pa0, pa1, pa2, pa3); partialSM(pA0, pA1, m_reg, mnA, alA);
    __syncthreads(); SWAIT(); SWRITE(1, SO);
    RESC(alA); __syncthreads();
  }
  SBAR(); qkt(pB0, pB1, (bf16*)((char*)K_lds + SHM_K), qr, r32, hi);
  finishSM(pA0, pA1, alA, l_reg, pa0, pa1, pa2, pa3); SBAR();
  pv_d0(o, vb0, pa0, pa1, pa2, pa3); partialSM(pB0, pB1, m_reg, mnB, alB);
  __syncthreads(); RESC(alB);
  finishSM(pB0, pB1, alB, l_reg, pa0, pa1, pa2, pa3); SBAR();
  pv_d0(o, vb0 + (int)SHM_V, pa0, pa1, pa2, pa3);
  if (hi == 0) li_l[r32] = l_reg; asm volatile("s_waitcnt lgkmcnt(0)" ::: "memory");
  float rli[16];
#pragma unroll
  for (int r = 0; r < 16; ++r) rli[r] = __builtin_amdgcn_rcpf(li_l[crow(r, hi)]);
  float* Ow = Ob + (long)(wid * QBLK) * LDO;
#pragma unroll
  for (int r = 0; r < 16; ++r) { int orow = crow(r, hi);
    for (int d0 = 0; d0 < 4; ++d0) Ow[(long)orow * LDO + d0 * 32 + r32] = o[d0][r] * rli[r]; }
#undef SLOAD
#undef SWRITE
#undef SWAIT
#undef RESC
}
constexpr size_t SHM_K64 = KVBLK * 64 * 2, SHM_ATTN64 = 2 * SHM_V + 2 * SHM_K64 + NW * 64 * 4;
#define KSWZ64(row, colB) ((row) * 128 + ((colB) ^ ((((row) >> 1) & 7) << 4)))
__device__ __forceinline__ void qkt64(f32x16& p0, f32x16& p1, const bf16* Ks, const bf16x8* qr, int r32, int hi) {
  p0 = f32x16{}; p1 = f32x16{};
  for (int d0 = 0; d0 < 4; ++d0) { int cb = (d0 * 16 + hi * 8) * 2;
    bf16x8 b0 = *reinterpret_cast<const bf16x8*>((const char*)Ks + KSWZ64(r32, cb));
    bf16x8 b1 = *reinterpret_cast<const bf16x8*>((const char*)Ks + KSWZ64(32 + r32, cb));
    p0 = __builtin_amdgcn_mfma_f32_32x32x16_bf16(b0, qr[d0], p0, 0, 0, 0);
    p1 = __builtin_amdgcn_mfma_f32_32x32x16_bf16(b1, qr[d0], p1, 0, 0, 0); }
}
template <int LDQ, int LDK, int LDV, int LDO>
__device__ __forceinline__ void attn_body64(const bf16* __restrict__ Qb, const bf16* __restrict__ Kh, const bf16* __restrict__ Vh,
                                                float* __restrict__ Ob, int seq, char* lds) {
  int tid = threadIdx.x; asm volatile("" : "+v"(tid));
  const int wid = tid >> 6, lane = tid & 63, r32 = lane & 31, hi = lane >> 5;
  bf16* V_lds = (bf16*)lds; bf16* K_lds = (bf16*)(lds + 2 * SHM_V);
  float* ws = (float*)(lds + 2 * SHM_V + 2 * SHM_K64) + wid * 64; float* li_l = ws; float* al_l = ws + 32;
  float m_reg = -1e30f, l_reg = 0; f32x16 o[4] = {}; bf16x8 qr[4];
  const bf16* Qw = Qb + (long)(wid * QBLK + r32) * LDQ + hi * 8;
#pragma unroll
  for (int d0 = 0; d0 < 4; ++d0) qr[d0] = *reinterpret_cast<const bf16x8*>(Qw + d0 * 16);
  const int sr = tid >> 4, sc = (tid & 15) * 8, vst0 = v_st(sr, sc), vst1 = v_st(32 + sr, sc);
  const int vb0 = (int)(uintptr_t)V_lds + v_rd_base(lane);
  const int kr = tid >> 3, kc = (tid & 7) * 8;
  const bf16* Vw = Vh + sr * LDV + sc; const bf16* Kw = Kh + kr * LDK + kc;
  struct { bf16x8 vs0, vs1, ks0; } sr_[SDEPTH];
#define SLOAD(i, k0) do { sr_[i].vs0 = *reinterpret_cast<const bf16x8*>(Vw + (k0) * LDV); sr_[i].vs1 = *reinterpret_cast<const bf16x8*>(Vw + ((k0) + 32) * LDV); \
    sr_[i].ks0 = *reinterpret_cast<const bf16x8*>(Kw + (k0) * LDK); } while (0)
#define SWRITE(b, i) do { *(bf16x8*)((char*)V_lds + (b) * SHM_V + vst0) = sr_[i].vs0;          \
    *(bf16x8*)((char*)V_lds + (b) * SHM_V + vst1) = sr_[i].vs1;               \
    *(bf16x8*)((char*)K_lds + (b) * SHM_K64 + KSWZ64(kr, kc * 2)) = sr_[i].ks0; } while (0)
#define SWAIT() do { asm volatile("s_waitcnt vmcnt(3)" ::: "memory"); } while (0)
#define RESC(a) do { if (__any((a) < 1.f)) { if (hi == 0) al_l[r32] = (a); asm volatile("s_waitcnt lgkmcnt(0)" ::: "memory"); \
    for (int d = 0; d < 4; ++d) for (int r = 0; r < 16; ++r) o[d][r] *= al_l[crow(r, hi)]; } } while (0)
  f32x16 pA0, pA1, pB0, pB1; float mnA, mnB, alA, alB; bf16x8 pa0, pa1, pa2, pa3; const int NT = seq / KVBLK;
  constexpr int SE = 0, SO = SDEPTH - 1;
  SLOAD(SE, 0); asm volatile("s_waitcnt vmcnt(0)" ::: "memory"); SWRITE(0, SE); __syncthreads();
  qkt64(pA0, pA1, K_lds, qr, r32, hi); partialSM(pA0, pA1, m_reg, mnA, alA);
  SLOAD(SO, KVBLK); if (2 < NT) SLOAD(SE, 2 * KVBLK);
  SWAIT(); SWRITE(1, SO); __syncthreads();
  for (int j = 1; j + 1 < NT; j += 2) {
    SBAR(); qkt64(pB0, pB1, (bf16*)((char*)K_lds + SHM_K64), qr, r32, hi);
    finishSM(pA0, pA1, alA, l_reg, pa0, pa1, pa2, pa3); SBAR();
    SLOAD(SO, (j + SDEPTH) * KVBLK); SBAR();
    pv_d0(o, vb0, pa0, pa1, pa2, pa3); partialSM(pB0, pB1, m_reg, mnB, alB);
    __syncthreads(); SWAIT(); SWRITE(0, SE);
    RESC(alB); __syncthreads();
    SBAR(); qkt64(pA0, pA1, K_lds, qr, r32, hi);
    finishSM(pB0, pB1, alB, l_reg, pa0, pa1, pa2, pa3); SBAR();
    if (j + 3 < NT) SLOAD(SE, (j + 1 + SDEPTH) * KVBLK); SBAR();
    pv_d0(o, vb0 + (int)SHM_V, pa0, pa1, pa2, pa3); partialSM(pA0, pA1, m_reg, mnA, alA);
    __syncthreads(); SWAIT(); SWRITE(1, SO);
    RESC(alA); __syncthreads();
  }
  SBAR(); qkt64(pB0, pB1, (bf16*)((char*)K_lds + SHM_K64), qr, r32, hi);
  finishSM(pA0, pA1, alA, l_reg, pa0, pa1, pa2, pa3); SBAR();
  pv_d0(o, vb0, pa0, pa1, pa2, pa3); partialSM(pB0, pB1, m_reg, mnB, alB);
  __syncthreads(); RESC(alB);
  finishSM(pB0, pB1, alB, l_reg, pa0, pa1, pa2, pa3); SBAR();
  pv_d0(o, vb0 + (int)SHM_V, pa0, pa1, pa2, pa3);
  if (hi == 0) li_l[r32] = l_reg; asm volatile("s_waitcnt lgkmcnt(0)" ::: "memory");
  float rli[16];
#pragma unroll
  for (int r = 0; r < 16; ++r) rli[r] = __builtin_amdgcn_rcpf(li_l[crow(r, hi)]);
  float* Ow = Ob + (long)(wid * QBLK) * LDO;
#pragma unroll
  for (int r = 0; r < 16; ++r) { int orow = crow(r, hi);
    for (int d0 = 0; d0 < 4; ++d0) Ow[(long)orow * LDO + d0 * 32 + r32] = o[d0][r] * rli[r]; }
#undef SLOAD
#undef SWRITE
#undef SWAIT
#undef RESC
}
}

__device__ __forceinline__ float silu_acc(float x) { return x / (1.f + expf(-x)); }

__device__ __forceinline__ void p0_modv(const Frame& F, const Args& a, int u) {
    const int l = u / 96, c0 = (u % 96) * 64, tid = F.tid;
    float* sc = (float*)F.lds;
    for (int i = tid; i < 9 * 1024; i += NTHR) { const int r = i >> 10, k = i & 1023; const float v = r < 8 ? a.in[I_C][r * 1024 + k] : a.in[I_CCTX][k]; sc[i] = silu_acc(v); }
    __syncthreads();
    const int col = tid & 63, kp = tid >> 6;
    float acc[9];
#pragma unroll
    for (int r = 0; r < 9; ++r) acc[r] = 0.f;
    const float* wm = a.in[I_WMOD] + (size_t)l * 1024 * 6144 + c0 + col;
    for (int k0 = kp * 128; k0 < kp * 128 + 128; k0 += 32) { float w[32];
#pragma unroll
        for (int i = 0; i < 32; ++i) w[i] = wm[(size_t)(k0 + i) * 6144];
#pragma unroll
        for (int i = 0; i < 32; ++i) {
#pragma unroll
            for (int r = 0; r < 9; ++r) acc[r] = fmaf(sc[r * 1024 + k0 + i], w[i], acc[r]); } }
    float* red = sc + 9 * 1024;
#pragma unroll
    for (int r = 0; r < 9; ++r) red[(kp * 9 + r) * 64 + col] = acc[r];
    __syncthreads();
    float* modv = wsp<float>(F, WS_MODV);
    for (int i = tid; i < 576; i += NTHR) { const int r = i >> 6, cc = i & 63; float s = 0.f;
        for (int q = 0; q < 8; ++q) s += red[(q * 9 + r) * 64 + cc];
        modv[((size_t)l * 9 + r) * 6144 + c0 + cc] = s + a.in[I_BMOD][l * 6144 + c0 + cc]; }
    __syncthreads();
}

__device__ __forceinline__ float hy_hidden(const Args& a, int l, int L, int t, int lane) {
    const float t01 = (float)t / (float)(L - 1);
    const float wpos = (float)(6.283185307179586 / L) * (float)t;
    const float* w1 = a.in[I_HYW1] + l * 17 * 64; const float* b1 = a.in[I_HYB1] + l * 64;
    const float* w2 = a.in[I_HYW2] + l * 64 * 64; const float* b2 = a.in[I_HYB2] + l * 64;
    const float* fq = a.in[I_HYFREQ] + l * 128;
    float av = fmaf(t01, w1[lane], b1[lane]);
#pragma unroll
    for (int j = 0; j < 8; ++j) { const float band = 1e-4f + (float)j * ((7.f - 1e-4f) / 7.f); const float ang = wpos * band;
        av = fmaf(cosf(ang), w1[(1 + j) * 64 + lane], av); av = fmaf(-sinf(ang), w1[(9 + j) * 64 + lane], av); }
    const float h1 = sinf(fq[lane] * av);
    float a2 = b2[lane];
    for (int j = 0; j < 64; ++j) a2 = fmaf(shi(h1, j), w2[j * 64 + lane], a2);
    return sinf(fq[64 + lane] * a2);
}
template <int NP>
__device__ __forceinline__ void hy_hiddenN(const Args& a, int l, int L, int t0, int ts, int lane, float (&out)[NP]) {
    const float* w1 = a.in[I_HYW1] + l * 17 * 64; const float* b1 = a.in[I_HYB1] + l * 64;
    const float* w2 = a.in[I_HYW2] + l * 64 * 64; const float* b2 = a.in[I_HYB2] + l * 64;
    const float* fq = a.in[I_HYFREQ] + l * 128;
    const int pi = lane >> 3, pj = lane & 7;
    const float band = 1e-4f + (float)pj * ((7.f - 1e-4f) / 7.f);
    const float ang = ((float)(6.283185307179586 / L) * (float)(t0 + ts * pi)) * band;
    const float cv = cosf(ang), sv = -sinf(ang);
    float w1r[17];
#pragma unroll
    for (int j = 0; j < 17; ++j) w1r[j] = w1[j * 64 + lane];
    const float b1v = b1[lane], b2v = b2[lane], f0 = fq[lane], f1 = fq[64 + lane];
    float h1[NP];
#pragma unroll
    for (int i = 0; i < NP; ++i) { const float t01 = (float)(t0 + ts * i) / (float)(L - 1);
        float av = fmaf(t01, w1r[0], b1v);
#pragma unroll
        for (int j = 0; j < 8; ++j) { av = fmaf(shi(cv, i * 8 + j), w1r[1 + j], av); av = fmaf(shi(sv, i * 8 + j), w1r[9 + j], av); }
        h1[i] = sinf(f0 * av); }
    float a2[NP];
#pragma unroll
    for (int i = 0; i < NP; ++i) a2[i] = b2v;
#pragma unroll 1
    for (int jb = 0; jb < 64; jb += 16) { float w2r[16];
#pragma unroll
        for (int j = 0; j < 16; ++j) w2r[j] = w2[(jb + j) * 64 + lane];
#pragma unroll
        for (int j = 0; j < 16; ++j) {
#pragma unroll
            for (int i = 0; i < NP; ++i) a2[i] = fmaf(shi(h1[i], jb + j), w2r[j], a2[i]); } }
#pragma unroll
    for (int i = 0; i < NP; ++i) out[i] = sinf(f1 * a2[i]);
}
__device__ __forceinline__ void p0_hytab(const Frame& F, const Args& a, int u) {
    const int l = 0, rr = 2048 + u * 8 + F.wave, lane = F.lane;
    const int L = rr < 2048 ? 2048 : 256, t = rr < 2048 ? rr : rr - 2048;
    wsp<float>(F, WS_HYT)[((size_t)l * 2304 + rr) * 64 + lane] = hy_hidden(a, l, L, t, lane);
}
__device__ __forceinline__ size_t kf_off(int c, int idx) { return ((size_t)(idx >> 6) * 256 + c) * 64 + (idx & 63); }
__device__ __forceinline__ void p0_hyfilt(const Frame& F, const Args& a, int u) {
    constexpr int L = SEQ;
    const int l = u >> 7, tb = (u >> 1) & 63, o = u & 1;
    float* h2s = (float*)F.lds;
    float* tile = h2s + 32 * 64;
    const int tid = F.tid, lane = F.lane, wave = F.wave;
    { float hv[4]; hy_hiddenN<4>(a, l, L, tb * 32 + wave, 8, lane, hv);
#pragma unroll
      for (int i = 0; i < 4; ++i) h2s[(wave + 8 * i) * 64 + lane] = hv[i]; }
    __syncthreads();
    const int c4 = (tid & 127) * 4, tg = tid >> 7;
    const float* w3 = a.in[I_HYW3] + (size_t)l * 64 * 1024 + o * 512 + c4;
    f32x4 acc[8];
#pragma unroll
    for (int r = 0; r < 8; ++r) acc[r] = (f32x4){0.f, 0.f, 0.f, 0.f};
#pragma unroll 1
    for (int ib = 0; ib < 64; ib += 8) { f32x4 wv[8];
#pragma unroll
        for (int k = 0; k < 8; ++k) wv[k] = *(const f32x4*)(w3 + (size_t)(ib + k) * 1024);
#pragma unroll
        for (int r = 0; r < 8; ++r) { const f32x4 h0 = *(const f32x4*)(h2s + (tg * 8 + r) * 64 + ib), h1 = *(const f32x4*)(h2s + (tg * 8 + r) * 64 + ib + 4);
            acc[r] += h0[0] * wv[0] + h0[1] * wv[1] + h0[2] * wv[2] + h0[3] * wv[3] + h1[0] * wv[4] + h1[1] * wv[5] + h1[2] * wv[6] + h1[3] * wv[7]; } }
    const float la = -3.0701134573253945f, lb = -15.350567286626973f;
#pragma unroll
    for (int q = 0; q < 4; ++q) { const int col = c4 + q; const float delta = fabsf(la + (float)(col & 255) * ((lb - la) / 255.f));
#pragma unroll
        for (int r = 0; r < 8; ++r) { const int t = tb * 32 + tg * 8 + r; tile[col * 33 + tg * 8 + r] = acc[r][q] * (expf(-((float)t / (float)(L - 1)) * delta) + 0.05f); } }
    __syncthreads();
    float* KF = wsp<float>(F, WS_KF) + ((size_t)(l * 2 + o) * 256) * 4096;
    for (int cc = wave * 2 + (lane >> 5); cc < 512; cc += 16) { const int dir = cc >> 8, c = cc & 255, tl = lane & 31, t = tb * 32 + tl;
        const int idx = dir == 0 ? L + t : (t == 0 ? 0 : L - t);
        KF[kf_off(c, idx)] = tile[cc * 33 + tl]; }
    __syncthreads();
}

__device__ __forceinline__ void p0_wg(const Frame& F, const Args& a, int l) {
    float* wg = wsp<float>(F, WS_WG) + l * 16 * 1024;
    const float* w = a.in[I_WIN] + (size_t)l * 1024 * INC + 1024;
    for (int i = F.tid; i < 16 * 1024; i += NTHR) { const int g = i & 15, k = i >> 4; wg[g * 1024 + k] = w[(size_t)k * INC + g]; }
}

__device__ __forceinline__ void transpose_tile(const Frame& F, const float* __restrict__ src, int lds_, int k0, int n0, bf16_t* __restrict__ dst, int ldd) {
    float* tile = (float*)F.lds;
    const int tid = F.tid, r = tid >> 4, c4 = (tid & 15) * 4;
#pragma unroll
    for (int i = 0; i < 2; ++i) { const f32x4 v = *(const f32x4*)(src + (size_t)(k0 + r + 32 * i) * lds_ + n0 + c4);
        float* tp = tile + (r + 32 * i) * 65 + c4; tp[0] = v[0]; tp[1] = v[1]; tp[2] = v[2]; tp[3] = v[3]; }
    __syncthreads();
    const int n = tid >> 3, ks = (tid & 7) * 8;
    float x[8];
#pragma unroll
    for (int j = 0; j < 8; ++j) x[j] = tile[(ks + j) * 65 + n];
    u32x4 w = {cvtpk(x[0], x[1]), cvtpk(x[2], x[3]), cvtpk(x[4], x[5]), cvtpk(x[6], x[7])};
    *(u32x4*)(dst + (size_t)n * ldd + k0 + ks) = w;
    __syncthreads();
}

template <class DRow>
__device__ __forceinline__ void transpose_wide(const Frame& F, const float* __restrict__ src, int lds_, int k0, int n0, bf16_t* __restrict__ dst, int ldd, DRow drow) {
    constexpr int KR = 128;
    float* tile = (float*)F.lds;
    int tid = threadIdx.x; asm volatile("" : "+v"(tid)); const int r = tid >> 6, c4 = (tid & 63) * 4;
    f32x4 v[KR / 8];
#pragma unroll
    for (int i = 0; i < KR / 8; ++i) v[i] = *(const f32x4*)(src + (size_t)(k0 + r + 8 * i) * lds_ + n0 + c4);
#pragma unroll
    for (int i = 0; i < KR / 8; ++i) { float* tp = tile + (r + 8 * i) * 261 + c4; tp[0] = v[i][0]; tp[1] = v[i][1]; tp[2] = v[i][2]; tp[3] = v[i][3]; }
    __syncthreads();
#pragma unroll
    for (int p = 0; p < KR / 16; ++p) { const int idx = tid + NTHR * p; const int n = (idx >> 4) & 255, ks = (idx & 15) * 8;
        float x[8];
#pragma unroll
        for (int j = 0; j < 8; ++j) x[j] = tile[(ks + j) * 261 + n];
        u32x4 w = {cvtpk(x[0], x[1]), cvtpk(x[2], x[3]), cvtpk(x[4], x[5]), cvtpk(x[6], x[7])};
        *(u32x4*)(dst + (size_t)drow(n) * ldd + k0 + ks) = w; }
    __syncthreads();
}
constexpr int TR_PER_LAYER = 832 + 256 + 192 + NE * 192;
__device__ __forceinline__ void p0_transpose(const Frame& F, const Args& a, int q) {
    const int l = q / TR_PER_LAYER; int r = q % TR_PER_LAYER;
    if (r < 832) { const int nt = r / 16, kt = r % 16; const int n0s = nt * 64 < 1024 ? nt * 64 : nt * 64 + 16;
        transpose_tile(F, a.in[I_WIN] + (size_t)l * 1024 * INC, INC, kt * 64, n0s, wsp<bf16_t>(F, WS_WIN) + ((size_t)l * NU + nt * 64) * 1024, 1024); return; }
    r -= 832;
    if (r < 256) { const int nt = r / 16, kt = r % 16;
        transpose_tile(F, a.in[I_WOUT] + (size_t)l * 1024 * 1024, 1024, kt * 64, nt * 64, wsp<bf16_t>(F, WS_WOUT) + ((size_t)l * 1024 + nt * 64) * 1024, 1024); return; }
    r -= 256;
    if (r < 128) { const int which = r / 64, rr = r % 64, nt = rr / 16, kt = rr % 16; const int drow = 256 * ((nt * 64) / 128) + (nt * 64) % 128 + which * 128;
        transpose_tile(F, a.in[which ? I_SW3 : I_SW1] + (size_t)l * 1024 * 256, 256, kt * 64, nt * 64, wsp<bf16_t>(F, WS_WSH13) + ((size_t)l * 512 + drow) * 1024, 1024); return; }
    r -= 128;
    if (r < 64) { const int nt = r / 4, kt = r % 4;
        transpose_tile(F, a.in[I_SW2] + (size_t)l * 256 * 1024, 1024, kt * 64, nt * 64, wsp<bf16_t>(F, WS_WSH2) + ((size_t)l * 1024 + nt * 64) * 256, 256); return; }
    r -= 64;
    const int e = r / 192, x = r % 192;
    if (x < 128) { const int which = x / 64, rr = x % 64, nt = rr / 16, kt = rr % 16; const int drow = 256 * ((nt * 64) / 128) + (nt * 64) % 128 + which * 128;
        transpose_tile(F, a.in[which ? I_EW3 : I_EW1] + ((size_t)l * NE + e) * 1024 * 256, 256, kt * 64, nt * 64, wsp<bf16_t>(F, WS_WE13) + (((size_t)l * NE + e) * 512 + drow) * 1024, 1024); return; }
    { const int rr = x - 128, nt = rr / 4, kt = rr % 4;
        transpose_tile(F, a.in[I_EW2] + ((size_t)l * NE + e) * 256 * 1024, 1024, kt * 64, nt * 64, wsp<bf16_t>(F, WS_WE2) + (((size_t)l * NE + e) * 1024 + nt * 64) * 256, 256); }
}

template <int NT, class DRow>
__device__ __forceinline__ void transpose_stream(const Frame& F, const float* __restrict__ src, int lds_, int k0, int n0, bf16_t* __restrict__ dst, int ldd, DRow drow) {
    float* tile = (float*)F.lds;
    int tid = threadIdx.x; asm volatile("" : "+v"(tid)); const int r = tid >> 6, c4 = (tid & 63) * 4;
    f32x4 v[8];
#pragma unroll
    for (int i = 0; i < 8; ++i) v[i] = __builtin_nontemporal_load((const f32x4*)(src + (size_t)(k0 + r + 8 * i) * lds_ + n0 + c4));
#pragma unroll 1
    for (int t = 0; t < NT; ++t) { float* tl = tile + (t & 1) * (64 * 261);
#pragma unroll
        for (int i = 0; i < 8; ++i) { float* tp = tl + (r + 8 * i) * 261 + c4; tp[0] = v[i][0]; tp[1] = v[i][1]; tp[2] = v[i][2]; tp[3] = v[i][3]; }
        if (t + 1 < NT) {
#pragma unroll
            for (int i = 0; i < 8; ++i) v[i] = __builtin_nontemporal_load((const f32x4*)(src + (size_t)(k0 + 64 * (t + 1) + r + 8 * i) * lds_ + n0 + c4)); }
        __syncthreads();
#pragma unroll
        for (int p = 0; p < 4; ++p) { const int idx = tid + NTHR * p; const int n = idx >> 3, ks = (idx & 7) * 8;
            float x[8];
#pragma unroll
            for (int j = 0; j < 8; ++j) x[j] = tl[(ks + j) * 261 + n];
            u32x4 w = {cvtpk(x[0], x[1]), cvtpk(x[2], x[3]), cvtpk(x[4], x[5]), cvtpk(x[6], x[7])};
            __builtin_nontemporal_store(w, (u32x4*)(dst + (size_t)drow(n) * ldd + k0 + 64 * t + ks)); }
    }
    __syncthreads();
}
__device__ __forceinline__ void expert_cvt_job(const Frame& F, int l, int q) {
    const int e = q / 6, x = q % 6;
    if (x < 4) { const int which = x >> 1, kh = x & 1;
        transpose_stream<8>(F, (which ? F.ew3 : F.ew1) + ((size_t)l * NE + e) * 1024 * 256, 256, kh * 512, 0, wsp<bf16_t>(F, WS_WE13) + ((size_t)l * NE + e) * 512 * 1024, 1024,
                            [which](int n) { return 256 * (n >> 7) + (n & 127) + 128 * which; }); }
    else { const int nh = x & 1;
        for (int nt = 0; nt < 2; ++nt)
            transpose_stream<4>(F, F.ew2 + ((size_t)l * NE + e) * 256 * 1024, 1024, 0, nh * 512 + nt * 256, wsp<bf16_t>(F, WS_WE2) + (((size_t)l * NE + e) * 1024 + nh * 512 + nt * 256) * 256, 256,
                                [](int n) { return n; }); }
}
__device__ __forceinline__ void p0_transpose_job(const Frame& F, const Args& a, int q) {
    const int l = q / 42; int r = q % 42;
    if (r < 26) { const int nt = r >> 1, kh = r & 1; const int n0s = nt * 256 < 1024 ? nt * 256 : nt * 256 + 16;
        transpose_stream<8>(F, a.in[I_WIN] + (size_t)l * 1024 * INC, INC, kh * 512, n0s, wsp<bf16_t>(F, WS_WIN) + ((size_t)l * NU + nt * 256) * 1024, 1024, [](int n) { return n; }); return; }
    r -= 26;
    if (r < 8) { const int nt = r >> 1, kh = r & 1;
        transpose_stream<8>(F, a.in[I_WOUT] + (size_t)l * 1024 * 1024, 1024, kh * 512, nt * 256, wsp<bf16_t>(F, WS_WOUT) + ((size_t)l * 1024 + nt * 256) * 1024, 1024, [](int n) { return n; }); return; }
    r -= 8;
    if (r < 4) { const int which = r >> 1, kh = r & 1;
        transpose_stream<8>(F, a.in[which ? I_SW3 : I_SW1] + (size_t)l * 1024 * 256, 256, kh * 512, 0, wsp<bf16_t>(F, WS_WSH13) + (size_t)l * 512 * 1024, 1024,
                            [which](int n) { return 256 * (n >> 7) + (n & 127) + 128 * which; }); return; }
    r -= 4;
    transpose_stream<4>(F, a.in[I_SW2] + (size_t)l * 256 * 1024, 1024, 0, r * 256, wsp<bf16_t>(F, WS_WSH2) + ((size_t)l * 1024 + r * 256) * 256, 256, [](int n) { return n; });
}
__device__ __forceinline__ void copy_par(const Frame& F, const float* __restrict__ src, int off, int n, int slot) {
    if (F.bid % 12 != slot) return;
    float* dst = (float*)(F.ws + WS_PAR) + off; const int g = F.bid / 12, ng = (F.G - slot + 11) / 12;
#pragma unroll 4
    for (int i = g * NTHR + F.tid; i < n; i += ng * NTHR) dst[i] = src[i];
}
__device__ __forceinline__ void p0_wr(const Frame& F, const Args& a, int q) {
        const int l = q >> 4, k0 = (q & 15) * 64; float* tile = (float*)F.lds; const float* rw = a.in[I_RW] + (size_t)l * 1024 * 256; bf16_t* wr = wsp<bf16_t>(F, WS_WR) + (size_t)l * 256 * 3072;
        for (int i = F.tid; i < 64 * 64; i += NTHR) { const int r = i >> 6, c4 = (i & 63) * 4; const f32x4 v = *(const f32x4*)(rw + (size_t)(k0 + r) * 256 + c4);
            float* tp = tile + r * 261 + c4; tp[0] = v[0]; tp[1] = v[1]; tp[2] = v[2]; tp[3] = v[3]; }
        __syncthreads();
        for (int idx = F.tid; idx < 256 * 8; idx += NTHR) { const int n = idx >> 3, ks = (idx & 7) * 8; float x[8], lo[8];
#pragma unroll
            for (int j = 0; j < 8; ++j) x[j] = tile[(ks + j) * 261 + n];
            u32x4 hi = {cvtpk(x[0], x[1]), cvtpk(x[2], x[3]), cvtpk(x[4], x[5]), cvtpk(x[6], x[7])};
#pragma unroll
            for (int j = 0; j < 8; ++j) lo[j] = x[j] - __uint_as_float((j & 1) ? (hi[j >> 1] & 0xffff0000u) : (hi[j >> 1] << 16));
            u32x4 lw = {cvtpk(lo[0], lo[1]), cvtpk(lo[2], lo[3]), cvtpk(lo[4], lo[5]), cvtpk(lo[6], lo[7])};
            bf16_t* d = wr + (size_t)n * 3072 + k0 + ks; *(u32x4*)d = hi; *(u32x4*)(d + 1024) = hi; *(u32x4*)(d + 2048) = lw; }
        __syncthreads();
}
__device__ __forceinline__ void prologue_units(const Frame& F, const Args& a, int lsel, int pidx, int np) {
    constexpr int N_HF = 128, N_MODV = 96, N_TRS = 42, N_WR = 16; const int n_hyt = lsel == 0 ? 32 : 0, ntot = N_HF + N_MODV + N_TRS + N_WR + n_hyt + 1;
    for (int u = pidx; u < ntot; u += np) {
        if (u < N_HF) p0_hyfilt(F, a, lsel * N_HF + u);
        else if (u < N_HF + N_MODV) p0_modv(F, a, lsel * N_MODV + u - N_HF);
        else if (u < N_HF + N_MODV + N_TRS) p0_transpose_job(F, a, lsel * N_TRS + u - N_HF - N_MODV);
        else if (u < N_HF + N_MODV + N_TRS + N_WR) p0_wr(F, a, lsel * N_WR + u - N_HF - N_MODV - N_TRS);
        else if (u < N_HF + N_MODV + N_TRS + N_WR + n_hyt) p0_hytab(F, a, u - N_HF - N_MODV - N_TRS - N_WR);
        else p0_wg(F, a, lsel);
    }
}
__device__ __forceinline__ void phase_prologue(const Frame& F0, const Args& a) {
    const Frame F = phase_frame(F0);
    copy_par(F, a.in[I_N1G], PAR_N1G, 2048, 0); copy_par(F, a.in[I_N2G], PAR_N2G, 2048, 1); copy_par(F, a.in[I_MLGB], PAR_MLGB, 32, 2); copy_par(F, a.in[I_MLNG], PAR_MLNG, 512, 2);
    copy_par(F, a.in[I_DAQG], PAR_DAQG, 128, 3); copy_par(F, a.in[I_DAKG], PAR_DAKG, 128, 3); copy_par(F, a.in[I_DALAM], PAR_DALAM, 512, 4); copy_par(F, a.in[I_DASUB], PAR_DASUB, 256, 4);
    copy_par(F, a.in[I_HYCW], PAR_HYCW, 4608, 5); copy_par(F, a.in[I_HYCB], PAR_HYCB, 1536, 6); copy_par(F, a.in[I_HYSKIP], PAR_HYSKIP, 1024, 7); copy_par(F, a.in[I_RB], PAR_RB, 512, 7);
    for (int s4 = 0; s4 < 4; ++s4) copy_par(F, a.in[I_HYW3] + s4 * 32768, PAR_HYW3 + s4 * 32768, 32768, 8 + s4);
    { float* rope = (float*)(F.ws + WS_PAR) + PAR_ROPER;
      for (int i = F.bid * NTHR + F.tid; i < 96 * 16; i += F.G * NTHR) { const int pos = i >> 4, j = i & 15; const float ang = (float)(pos < 32 ? pos : pos - 32) * powf(10000.f, -(float)j / 16.f);
          rope[2 * i] = cosf(ang); rope[2 * i + 1] = sinf(ang); } }
    prologue_units(F, a, 0, F.bid, F.G);
}
constexpr int NCVTJ = NE * 6;
__device__ __forceinline__ int cvt_next(const Frame& F, int l) {
    volatile int* slot = (volatile int*)(F.lds + LDS_BYTES - 32);
    __syncthreads();
    if (F.tid == 0) *slot = (int)__hip_atomic_fetch_add((unsigned*)(F.ws + CTL_WQ) + 64 * (2 + l), 1u, __ATOMIC_RELAXED, __HIP_MEMORY_SCOPE_AGENT);
    __syncthreads();
    const int j = *slot;
    __syncthreads();
    return j;
}
__device__ __forceinline__ void cvt_pull(const Frame& F0, int l, int maxjobs) {
    const Frame F = phase_frame(F0);
    for (int k = 0; k < maxjobs; ++k) { const int j = cvt_next(F, l); if (j >= NCVTJ) break; expert_cvt_job(F, l, j); }
}
__device__ __forceinline__ void expert_cvt_unit(const Frame& F, int l, int q) {
    const int e = q / 24, x = q % 24;
    if (x < 16) { const int which = x >> 3, kt = x & 7;
        transpose_wide(F, (which ? F.ew3 : F.ew1) + ((size_t)l * NE + e) * 1024 * 256, 256, kt * 128, 0, wsp<bf16_t>(F, WS_WE13) + ((size_t)l * NE + e) * 512 * 1024, 1024,
                       [which](int n) { return 256 * (n >> 7) + (n & 127) + 128 * which; }); }
    else { const int y = x - 16, kt = y & 1, nt = y >> 1;
        transpose_wide(F, F.ew2 + ((size_t)l * NE + e) * 256 * 1024, 1024, kt * 128, nt * 256, wsp<bf16_t>(F, WS_WE2) + (((size_t)l * NE + e) * 1024 + nt * 256) * 256, 256,
                       [](int n) { return n; }); }
}

__device__ __forceinline__ void phase_norm1(const Frame& F0, int l) {
    const Frame F = phase_frame(F0);
    float* wg = (float*)F.lds;
    if (l < 2) { const float* wgs = wsp<float>(F, WS_WG) + l * 16 * 1024; for (int i = F.tid; i < 16 * 1024; i += NTHR) wg[i] = wgs[i]; }
    __syncthreads();
    const int lane = F.lane;
    float* XL = wsp<float>(F, WS_XL); bf16_t* H = wsp<bf16_t>(F, WS_H); float* GATE = wsp<float>(F, WS_GATE) + (size_t)(l & 1) * T * 16;
    const float* modv = wsp<float>(F, WS_MODV);
    const bf16_t* Y = wsp<bf16_t>(F, WS_Y); const bf16_t* YSH = wsp<bf16_t>(F, WS_YSH);
    for (int t = F.bid * 8 + F.wave; t < T; t += F.G * 8) {
        const int b = t / TB, p = t % TB; const bool isctx = p < CTX; const int mrow = isctx ? 8 : b;
        if (l == 2 && isctx) continue;
        f32x4 xv[4];
        if (l == 0) { const float* src = isctx ? F.ctx + ((size_t)b * CTX + p) * D : F.x + ((size_t)b * SEQ + (p - CTX)) * D;
#pragma unroll
            for (int i = 0; i < 4; ++i) xv[i] = *(const f32x4*)(src + 4 * lane + 256 * i);
        } else {
            const float* g2 = modv + ((size_t)(l - 1) * 9 + mrow) * 6144 + 5 * 1024;
#pragma unroll
            for (int i = 0; i < 4; ++i) { const int k = 4 * lane + 256 * i;
                xv[i] = *(const f32x4*)(XL + (size_t)t * D + k);
                f32x4 y = {0.f, 0.f, 0.f, 0.f};
#pragma unroll
                for (int s = 0; s < 8; ++s) { const u32x2 w = *(const u32x2*)(Y + ((size_t)t * 8 + s) * D + k);
                    y[0] += __uint_as_float(w[0] << 16); y[1] += __uint_as_float(w[0] & 0xffff0000u); y[2] += __uint_as_float(w[1] << 16); y[3] += __uint_as_float(w[1] & 0xffff0000u); }
                { const u32x2 w = *(const u32x2*)(YSH + (size_t)t * D + k);
                    y[0] += __uint_as_float(w[0] << 16); y[1] += __uint_as_float(w[0] & 0xffff0000u); y[2] += __uint_as_float(w[1] << 16); y[3] += __uint_as_float(w[1] & 0xffff0000u); }
                const f32x4 g = *(const f32x4*)(g2 + k);
                xv[i] += g * y; }
        }
        if (l == 2) { if (!isctx) { float* o = F.out + ((size_t)b * SEQ + (p - CTX)) * D;
#pragma unroll
                for (int i = 0; i < 4; ++i) *(f32x4*)(o + 4 * lane + 256 * i) = xv[i]; }
            continue; }
        const float* mv = modv + ((size_t)l * 9 + mrow) * 6144;
        const float* ng = par(F, PAR_N1G) + l * 1024;
        f32x4 pg[4], psh[4], psc[4];
#pragma unroll
        for (int i = 0; i < 4; ++i) { const int k = 4 * lane + 256 * i; pg[i] = *(const f32x4*)(ng + k); psh[i] = *(const f32x4*)(mv + k); psc[i] = *(const f32x4*)(mv + 1024 + k); }
        float ss = 0.f;
#pragma unroll
        for (int i = 0; i < 4; ++i) { *(f32x4*)(XL + (size_t)t * D + 4 * lane + 256 * i) = xv[i]; ss += xv[i][0] * xv[i][0] + xv[i][1] * xv[i][1] + xv[i][2] * xv[i][2] + xv[i][3] * xv[i][3]; }
        ss = wsum(ss, lane);
        const float rr = rsqrtf(ss * (1.f / 1024.f) + EPS);
        f32x4 hv[4];
#pragma unroll
        for (int i = 0; i < 4; ++i) { const int k = 4 * lane + 256 * i;
            const f32x4 g = pg[i], sh = psh[i], sc = psc[i];
            hv[i] = (xv[i] * rr) * g * (sc + 1.f) + sh;
            u32x2 w = {cvtpk(hv[i][0], hv[i][1]), cvtpk(hv[i][2], hv[i][3])};
            *(u32x2*)(H + (size_t)t * D + k) = w; }
        float ga[16];
#pragma unroll
        for (int g = 0; g < 16; ++g) { float a = 0.f;
#pragma unroll
            for (int i = 0; i < 4; ++i) { const f32x4 w = *(const f32x4*)(wg + g * 1024 + 4 * lane + 256 * i); a += hv[i][0] * w[0] + hv[i][1] * w[1] + hv[i][2] * w[2] + hv[i][3] * w[3]; }
            ga[g] = a; }
#pragma unroll
        for (int o = 32; o >= 1; o >>= 1) {
#pragma unroll
            for (int g = 0; g < 16; ++g) ga[g] += shx(ga[g], o, lane); }
        float myg = 0.f;
#pragma unroll
        for (int g = 0; g < 16; ++g) if (lane == g) myg = ga[g];
        if (lane < 16) GATE[(size_t)t * 16 + lane] = myg + par(F, PAR_MLGB)[l * 16 + lane];
    }
    __syncthreads();
}

#define EPI_ROWS(...) _Pragma("unroll") for (int ai = 0; ai < 2; ++ai) _Pragma("unroll") for (int m = 0; m < 4; ++m) { const int row = ai * 128 + wr * 64 + m * 16 + fr; __VA_ARGS__ }
#define EPI_COLS(...) _Pragma("unroll") for (int bj = 0; bj < 2; ++bj) { const int col = bj * 128 + wc * 32 + fq * 8; __VA_ARGS__ }
#define EPI_NOPRE struct Pre {}; __device__ __forceinline__ Pre pre(int, int, int, int) const { return Pre{}; } __device__ __forceinline__ void land(Pre&) const {}
struct EpiStoreBf16 { bf16_t* C; int ldc;
    EPI_NOPRE
    __device__ __forceinline__ void operator()(const f32x4 (&acc)[2][2][4][2], int wr, int wc, int fr, int fq, int ct, const Pre& pr) const {
        EPI_ROWS( bf16_t* rp = C + (size_t)row * ldc + ct * 256; EPI_COLS( const f32x4 v = acc[ai][bj][m][0], v2 = acc[ai][bj][m][1]; u32x4 w = {cvtpk(v[0], v[1]), cvtpk(v[2], v[3]), cvtpk(v2[0], v2[1]), cvtpk(v2[2], v2[3])}; *(u32x4*)(rp + col) = w; ) )
    } };
struct EpiStoreF32 { float* C; int ldc;
    EPI_NOPRE
    __device__ __forceinline__ void operator()(const f32x4 (&acc)[2][2][4][2], int wr, int wc, int fr, int fq, int ct, const Pre& pr) const {
        EPI_ROWS( float* rp = C + (size_t)row * ldc; EPI_COLS( *(f32x4*)(rp + col) = acc[ai][bj][m][0]; *(f32x4*)(rp + col + 4) = acc[ai][bj][m][1]; ) )
    } };
struct EpiStoreT { bf16_t* Ct; int ldt;
    EPI_NOPRE
    __device__ __forceinline__ void operator()(const f32x4 (&acc)[2][2][4][2], int wr, int wc, int fr, int fq, int ct, const Pre& pr) const {
#pragma unroll
        for (int bj = 0; bj < 2; ++bj)
#pragma unroll
        for (int n = 0; n < 2; ++n) { bf16_t* cp = Ct + (size_t)(bj * 128 + wc * 32 + n * 16 + fr) * ldt + wr * 64 + fq * 4;
#pragma unroll
            for (int ai = 0; ai < 2; ++ai)
#pragma unroll
            for (int m = 0; m < 4; ++m) { const f32x4 v = acc[ai][bj][m][n]; u32x2 w = {cvtpk(v[0], v[1]), cvtpk(v[2], v[3])}; *(u32x2*)(cp + ai * 128 + m * 16) = w; } }
    } };
struct EpiResidual { float* X; const float* g;
    EPI_NOPRE
    __device__ __forceinline__ void operator()(const f32x4 (&acc)[2][2][4][2], int wr, int wc, int fr, int fq, int ct, const Pre& pr) const {
        f32x4 gv[2][2];
        EPI_COLS( gv[bj][0] = *(const f32x4*)(g + col); gv[bj][1] = *(const f32x4*)(g + col + 4); )
        EPI_ROWS( float* rp = X + (size_t)row * 1024; EPI_COLS( f32x4 x = *(const f32x4*)(rp + col), x2 = *(const f32x4*)(rp + col + 4); x += gv[bj][0] * acc[ai][bj][m][0]; x2 += gv[bj][1] * acc[ai][bj][m][1];
            *(f32x4*)(rp + col) = x; *(f32x4*)(rp + col + 4) = x2; ) )
    } };
struct EpiSwiGLU { bf16_t* Gt;
    EPI_NOPRE
    __device__ __forceinline__ void operator()(const f32x4 (&acc)[2][2][4][2], int wr, int wc, int fr, int fq, int ct, const Pre& pr) const {
        EPI_ROWS( bf16_t* rp = Gt + (size_t)row * 256;
            { const f32x4 a = acc[ai][0][m][0], c = acc[ai][1][m][0], a2 = acc[ai][0][m][1], c2 = acc[ai][1][m][1];
                u32x4 w = {cvtpk(siluf_(a[0]) * c[0], siluf_(a[1]) * c[1]), cvtpk(siluf_(a[2]) * c[2], siluf_(a[3]) * c[3]), cvtpk(siluf_(a2[0]) * c2[0], siluf_(a2[1]) * c2[1]), cvtpk(siluf_(a2[2]) * c2[2], siluf_(a2[3]) * c2[3])};
                *(u32x4*)(rp + wc * 32 + fq * 8) = w; } )
    } };
struct EpiScatterY { bf16_t* Y; const int* list2; int cnt, pos0, dump;
    struct Pre { int slot[8]; float w[8]; };
    __device__ __forceinline__ Pre pre(int wr, int wc, int fr, int fq) const { Pre p;
#pragma unroll
        for (int i = 0; i < 8; ++i) { const i32x2 v = *(const i32x2*)(list2 + 2 * (size_t)min(pos0 + (i >> 2) * 128 + wr * 64 + (i & 3) * 16 + fr, cnt - 1)); p.slot[i] = pos0 + (i >> 2) * 128 + wr * 64 + (i & 3) * 16 + fr < cnt ? v[0] : dump; p.w[i] = __int_as_float(v[1]); }
        return p; }
    __device__ __forceinline__ void land(Pre& p) const {
#pragma unroll
        for (int i = 0; i < 8; ++i) asm volatile("" : "+v"(p.slot[i]), "+v"(p.w[i])); }
    __device__ __forceinline__ void operator()(const f32x4 (&acc)[2][2][4][2], int wr, int wc, int fr, int fq, int ct, const Pre& pr) const {
#pragma unroll
        for (int ai = 0; ai < 2; ++ai) {
#pragma unroll
            for (int m = 0; m < 4; ++m) {
                { bf16_t* rp = Y + (size_t)pr.slot[ai * 4 + m] * 1024 + ct * 256; const float wv = pr.w[ai * 4 + m];
                    EPI_COLS( const f32x4 v = acc[ai][bj][m][0] * wv, v2 = acc[ai][bj][m][1] * wv; u32x4 o = {cvtpk(v[0], v[1]), cvtpk(v[2], v[3]), cvtpk(v2[0], v2[1]), cvtpk(v2[2], v2[3])}; *(u32x4*)(rp + col) = o; ) } } }
    } };

struct EpiPrepQK { bf16_t* dst; const float* gain; const float* ropeR; const float* ropeC; float* ssq  ; int b, pb  , g0;
    EPI_NOPRE
    __device__ __forceinline__ void operator()(const f32x4 (&acc)[2][2][4][2], int wr, int wc, int fr, int fq, int ct, const Pre& pr) const {
        const int lane = fq * 16 + fr;
#pragma unroll
        for (int ai = 0; ai < 2; ++ai)
#pragma unroll
        for (int m = 0; m < 4; ++m) { const int row = ai * 128 + wr * 64 + m * 16 + fr;
#pragma unroll
            for (int bj = 0; bj < 2; ++bj) { const f32x4 a0 = acc[ai][bj][m][0], a1 = acc[ai][bj][m][1];
                float sq = a0[0] * a0[0] + a0[1] * a0[1] + a0[2] * a0[2] + a0[3] * a0[3] + a1[0] * a1[0] + a1[1] * a1[1] + a1[2] * a1[2] + a1[3] * a1[3];
                sq += shx(sq, 16, lane); sq += shx(sq, 32, lane);
                if (fq == 0) ssq[(row * 4 + bj * 2 + (wc >> 1)) * 2 + (wc & 1)] = sq; } }
        asm volatile("s_waitcnt lgkmcnt(0)" ::: "memory"); __builtin_amdgcn_s_barrier(); asm volatile("" ::: "memory");
        const int c8 = (wc & 1) * 32 + 8 * fq, part = c8 >> 4, e0 = c8 & 15; const float sg = (part & 1) ? 1.f : -1.f;
        const f32x4 g0v = *(const f32x4*)(gain + c8), g1v = *(const f32x4*)(gain + c8 + 4);
#pragma unroll
        for (int ai = 0; ai < 2; ++ai) {
        f32x4 csh[4][4];
        if (pb != 0) {
#pragma unroll
            for (int m = 0; m < 4; ++m) { const int sp = (pb - 1) * 256 + ai * 128 + wr * 64 + m * 16 + fr; const float* tb = (part < 2 ? ropeR + (sp >> 6) * 32 : ropeC + (sp & 63) * 32) + 2 * e0;
#pragma unroll
                for (int q = 0; q < 4; ++q) csh[m][q] = *(const f32x4*)(tb + 4 * q); } }
#pragma unroll
        for (int m = 0; m < 4; ++m) { const int row = ai * 128 + wr * 64 + m * 16 + fr, p = pb * 256 + row;
            f32x4 cs[4];
#pragma unroll
            for (int q = 0; q < 4; ++q) cs[q] = csh[m][q];
#pragma unroll
            for (int bj = 0; bj < 2; ++bj) { const int h = bj * 2 + (wc >> 1);
                const float tot = ssq[(row * 4 + h) * 2] + ssq[(row * 4 + h) * 2 + 1]; const float rr = rsqrtf(tot * (1.f / 64.f) + EPS);
                f32x4 v0 = acc[ai][bj][m][0] * rr * g0v, v1 = acc[ai][bj][m][1] * rr * g1v;
                if (pb != 0) { float v[8] = {v0[0], v0[1], v0[2], v0[3], v1[0], v1[1], v1[2], v1[3]};
#pragma unroll
                    for (int q = 0; q < 8; ++q) { const float o = shx(v[q], 32, lane); v[q] = v[q] * cs[q >> 1][(q & 1) * 2] + sg * o * cs[q >> 1][(q & 1) * 2 + 1]; }
                    v0 = (f32x4){v[0], v[1], v[2], v[3]}; v1 = (f32x4){v[4], v[5], v[6], v[7]}; }
                u32x4 w = {cvtpk(v0[0], v0[1]), cvtpk(v0[2], v0[3]), cvtpk(v1[0], v1[1]), cvtpk(v1[2], v1[3])};
                *(u32x4*)(dst + (((size_t)b * 8 + g0 + h) * TB + p) * 64 + c8) = w; } } }
    } };

__device__ __forceinline__ int label_panel(int xl, int i) { return i < 8 ? xl + 8 * (i < xl ? i : i + 1) : 9 * xl; }
template <class Make, class Run>
__device__ __forceinline__ void gemm_stream(int first, int stride, int n, Make make, Run run) {
    int u = first; if (u >= n) return;
    g8::GU cur = make(u); bool pf = false;
    while (u < n) { const int un = u + stride; const bool hn = un < n; const g8::GU nx = hn ? make(un) : cur; pf = run(u, un, cur, pf, hn, nx); cur = nx; u = un; }
}

__device__ __forceinline__ void phase_gemm_in(const Frame& F0, int l) {
    const Frame F = phase_frame(F0);
    const bf16_t* H = wsp<bf16_t>(F, WS_H); const bf16_t* W = wsp<bf16_t>(F, WS_WIN) + (size_t)l * NU * 1024; bf16_t* U = wsp<bf16_t>(F, WS_U); bf16_t* UH = wsp<bf16_t>(F, WS_UH);
    const int xl = F.bid & 7, rk = F.bid >> 3, nr = F.G >> 3;
    const int nctx = l == 1 ? 10 : 13;
    gemm_stream(rk, nr, 8 * 13 + nctx,
        [&](int j) { const int pan = label_panel(xl, j < 104 ? j / 13 : 8), tl = j < 104 ? j % 13 : j - 104; return g8::GU{H, W + (size_t)tl * 256 * 1024, pan * 256, 0, 0}; },
        [&](int j, int jn, const g8::GU& cur, bool pf, bool hn, const g8::GU& nx) -> bool { const int pan = label_panel(xl, j < 104 ? j / 13 : 8), tl = j < 104 ? j % 13 : j - 104; const int rb = pan * 256;
            const int tln = jn < 104 ? jn % 13 : jn - 104;
            const bool hn2 = hn && ((tl < 10) == (tln < 10));
            if (tl >= 4 && tl < 8) { EpiPrepQK E{wsp<bf16_t>(F, tl < 6 ? WS_QN : WS_KN), par(F, tl < 6 ? PAR_DAQG : PAR_DAKG) + l * 64, par(F, PAR_ROPER), par(F, PAR_ROPEC), (float*)(F.lds + 135168), pan / 9, pan % 9, (tl & 1) * 4};
                g8::gemm256<false, 0, true, 1, 16>(F.lds, cur, 1024, 1024, E, pf, hn2, nx); }
            else if (tl < 10) { EpiStoreBf16 E{U + (size_t)rb * NU + tl * 256, NU}; g8::gemm256<false, 0, true, 1, 16>(F.lds, cur, 1024, 1024, E, pf, hn2, nx); }
            else { EpiStoreT E{UH + (size_t)(tl - 10) * 256 * T + rb, T}; g8::gemm256<false, 0, false, 1, 16>(F.lds, cur, 1024, 1024, E, pf, hn2, nx); }
            return hn2; });
    __syncthreads();
    { const int n = 8 * 13 + nctx; if (n % nr != 0 && rk >= n % nr) cvt_pull(F0, l, 2); }
}
__device__ __forceinline__ void phase_gemm_out(const Frame& F0, const Args& a, int l) {
    const Frame F = phase_frame(F0);
    const bf16_t* A = wsp<bf16_t>(F, WS_MIX); const bf16_t* W = wsp<bf16_t>(F, WS_WOUT) + (size_t)l * 1024 * 1024; float* XL = wsp<float>(F, WS_XL);
    const float* modv = wsp<float>(F, WS_MODV);
    const int xl = F.bid & 7, rk = F.bid >> 3, nr = F.G >> 3;
    gemm_stream(rk, nr, (l == 1 ? 8 : 9) * 4,
        [&](int j) { const int pan = label_panel(xl, j / 4), tl = j % 4; return g8::GU{A, W + (size_t)tl * 256 * 1024, pan * 256, 0, 0}; },
        [&](int j, int jn, const g8::GU& cur, bool pf, bool hn, const g8::GU& nx) -> bool { const int pan = label_panel(xl, j / 4), tl = j % 4; const int rb = pan * 256; const int mrow = (pan % 9 == 0) ? 8 : pan / 9;
            EpiResidual E{XL + (size_t)rb * 1024 + tl * 256, modv + ((size_t)l * 9 + mrow) * 6144 + 2 * 1024 + tl * 256};
            g8::gemm256<false, 0, true, 1, 32>(F.lds, cur, 1024, 1024, E, pf, hn, nx); return hn; });
    __syncthreads();
    const int nu = (l == 1 ? 8 : 9) * 4;
    if (l == 0 && nu > nr && rk >= nu - nr) { const Frame F2 = phase_frame(F0); prologue_units(F2, a, 1, (rk - (nu - nr)) * 8 + xl, (nr - (nu - nr)) * 8);
        if ((rk - (nu - nr)) * 8 + xl >= 128) cvt_pull(F0, 1, 1); }
}


__device__ __forceinline__ void attn_unit(const Frame& F, int l, int b, int g, int qb) {
    const att::bf16* QN = (const att::bf16*)wsp<bf16_t>(F, WS_QN); const att::bf16* KN = (const att::bf16*)wsp<bf16_t>(F, WS_KN);
    const att::bf16* U = (const att::bf16*)wsp<bf16_t>(F, WS_U); float* O = wsp<float>(F, WS_O);
    const int p0 = qb < 8 ? CTX + qb * 256 : 0, seq = qb < 8 ? TB : CTX;
    const att::bf16* Qb = QN + (((size_t)b * 8 + g) * TB + p0) * 64;
    const att::bf16* Kh = KN + (((size_t)b * 8 + g) * TB) * 64;
    const att::bf16* Vh = U + ((size_t)b * TB) * NU + 2048 + (g >> 1) * 128;
    float* Ob = O + ((size_t)b * TB + p0) * 1024 + g * 128;
    att::attn_body64<64, 64, NU, 1024>(Qb, Kh, Vh, Ob, seq, F.lds);
    __syncthreads();
}

__device__ __forceinline__ f32x4 mm16(const bf16_t* A, int lda, const bf16_t* B, int ldb, int K, f32x4 acc, int lane) {
    const int r = lane & 15, q = lane >> 4;
#ifdef MM16_SCALAR
    for (int k0 = 0; k0 < K; k0 += 8) { const bf16x8 b = *(const bf16x8*)(B + r * ldb + k0);
#pragma unroll
        for (int i = 0; i < 4; ++i) { const bf16x8 a = *(const bf16x8*)(A + (q * 4 + i) * lda + k0);
#pragma unroll
            for (int j = 0; j < 8; ++j) acc[i] = fmaf(bf2f((bf16_t)a[j]), bf2f((bf16_t)b[j]), acc[i]); } }
    return acc;
#endif
    for (int k0 = 0; k0 < K; k0 += 32) {
        const bf16x8 a = *(const bf16x8*)(A + r * lda + k0 + q * 8), b = *(const bf16x8*)(B + r * ldb + k0 + q * 8);
        acc = __builtin_amdgcn_mfma_f32_16x16x32_bf16(a, b, acc, 0, 0, 0); }
    asm volatile("s_nop 15\n\ts_nop 15" : "+v"(acc));
    return acc;
}

__device__ __forceinline__ int mlstm_pos(int dir, int c, int r) { const int tau = c * 64 + r; return dir == 0 ? tau : (c < 4 ? 255 - tau : 2559 - tau); }
__device__ __forceinline__ void mlstm_unit(const Frame& F, int l, int b, int h, int dir) {
    constexpr int LDW = 72, NCH = 36, OPB = 4 * 64 * LDW;
    bf16_t* OP = (bf16_t*)F.lds;
    bf16_t* wkT = OP + 2 * OPB; bf16_t* Sb = wkT + 64 * LDW; bf16_t* Cb = Sb + 64 * LDW;
    float* fb = (float*)(Cb + 64 * LDW);
    float* tb = fb;
    float* ta = tb + NCH * 64;
    float* tm = ta + NCH * 64;
    float* cM = tm + NCH * 64;
    float* den = cM + 5 * 64; float* nq = den + 256; float* nvec = nq + 64;
    int tid = threadIdx.x; asm volatile("" : "+v"(tid)); const int lane = tid & 63, wave = __builtin_amdgcn_readfirstlane(tid >> 6);
    const bf16_t* U = wsp<bf16_t>(F, WS_U); const float* GATE = wsp<float>(F, WS_GATE) + (size_t)l * T * 16; float* OUT = wsp<float>(F, dir ? WS_HB : WS_HF);
    for (int c = wave; c < NCH; c += 8) { const size_t tk = (size_t)b * TB + mlstm_pos(dir, c, lane);
        const float gi = GATE[tk * 16 + dir * 8 + h], f = GATE[tk * 16 + dir * 8 + 4 + h];
        float bc = fminf(f, 0.f) - log1pf(expf(-fabsf(f)));
        for (int o = 1; o < 64; o <<= 1) { const float x = shup(bc, o, lane); if (lane >= o) bc += x; }
        const float av = gi - bc; float am = av;
        for (int o = 1; o < 64; o <<= 1) { const float x = shup(am, o, lane); if (lane >= o) am = fmaxf(am, x); }
        tb[c * 64 + lane] = bc; ta[c * 64 + lane] = av; tm[c * 64 + lane] = am;
        if (lane == 63) { cM[64 + c] = bc; cM[128 + c] = am; } }
    for (int i = tid; i < 64 * LDW; i += NTHR) Cb[i] = 0;
    if (tid < 64) nvec[tid] = 0.f;
    __syncthreads();
    if (tid == 0) { float m = -1e30f;
        for (int c = 0; c < NCH; ++c) { const float bend = cM[64 + c], mnew = fmaxf(bend + m, bend + cM[128 + c]); cM[c] = m; cM[192 + c] = expf(bend + m - mnew); cM[256 + c] = mnew; m = mnew; } }
    const int row = tid >> 3, seg = tid & 7;
    bf16x8 pq, pk, pv;
#define ML_LOAD(c) do { const bf16_t* up = U + ((size_t)b * TB + mlstm_pos(dir, (c), row)) * NU + h * 64 + seg * 8; pq = *(const bf16x8*)up; pk = *(const bf16x8*)(up + 256); pv = *(const bf16x8*)(up + 512); } while (0)
#define ML_WRITE(buf) do { bf16_t* qs_ = OP + (buf) * OPB; bf16_t* ks_ = qs_ + 64 * LDW; bf16_t* kT_ = ks_ + 64 * LDW; bf16_t* vT_ = kT_ + 64 * LDW; \
        *(bf16x8*)(qs_ + row * LDW + seg * 8) = pq; bf16x8 k8; \
        _Pragma("unroll") for (int j = 0; j < 8; ++j) { const bf16_t kk = f2bf(bf2f((bf16_t)pk[j]) * 0.125f); k8[j] = (short)kk; kT_[(seg * 8 + j) * LDW + row] = kk; vT_[(seg * 8 + j) * LDW + row] = (bf16_t)pv[j]; } \
        *(bf16x8*)(ks_ + row * LDW + seg * 8) = k8; } while (0)
    ML_LOAD(0); ML_WRITE(0); ML_LOAD(1);
    f32x4 Cst[2] = {{0.f, 0.f, 0.f, 0.f}, {0.f, 0.f, 0.f, 0.f}};
    __syncthreads();
    for (int c = 0; c < NCH; ++c) {
        const int cur = c & 1;
        const bf16_t* qs = OP + cur * OPB; const bf16_t* ks = qs + 64 * LDW; const bf16_t* kT = ks + 64 * LDW; const bf16_t* vT = kT + 64 * LDW;
        const float mc = cM[c], bend = cM[64 + c], decay = cM[192 + c], mnew = cM[256 + c];
        const float* ca = ta + c * 64; const float* cm = tm + c * 64; const float* cbv = tb + c * 64;
        f32x4 Cq[2];
#pragma unroll
        for (int ti = 0; ti < 2; ++ti) { const int tl = wave * 2 + ti, tr = tl >> 2, tc = tl & 3; const int r = lane & 15, q = lane >> 4;
            f32x4 raw = mm16(qs + tr * 16 * LDW, LDW, ks + tc * 16 * LDW, LDW, 64, (f32x4){0.f, 0.f, 0.f, 0.f}, lane);
            const int sI = tc * 16 + r; const float as = ca[sI];
#pragma unroll
            for (int i = 0; i < 4; ++i) { const int t = tr * 16 + q * 4 + i; float val = 0.f; if (sI <= t) val = raw[i] * fexp(as - fmaxf(mc, cm[t]));
                Sb[t * LDW + sI] = f2bf(val);
                const float rs = rowsum16(val);
                if (r == 0) den[t * 4 + tc] = rs; }
            Cq[ti] = mm16(qs + tr * 16 * LDW, LDW, Cb + tc * 16 * LDW, LDW, 64, (f32x4){0.f, 0.f, 0.f, 0.f}, lane); }
        float wsum_k;
        { const int d = tid >> 3; const bf16x8 kk = *(const bf16x8*)(kT + d * LDW + seg * 8); const f32x4 a0 = *(const f32x4*)(ca + seg * 8), a1 = *(const f32x4*)(ca + seg * 8 + 4);
          float wv[8];
#pragma unroll
          for (int j = 0; j < 8; ++j) wv[j] = bf2f((bf16_t)kk[j]) * fexp(bend + (j < 4 ? a0[j & 3] : a1[j & 3]) - mnew);
          u32x4 w = {cvtpk(wv[0], wv[1]), cvtpk(wv[2], wv[3]), cvtpk(wv[4], wv[5]), cvtpk(wv[6], wv[7])};
          *(u32x4*)(wkT + d * LDW + seg * 8) = w;
          wsum_k = 0.f;
#pragma unroll
          for (int j = 0; j < 8; ++j) wsum_k += __uint_as_float(j & 1 ? (w[j >> 1] & 0xffff0000u) : (w[j >> 1] << 16)); }
        { const bf16x8 qq = *(const bf16x8*)(qs + row * LDW + seg * 8); const f32x4 n0 = *(const f32x4*)(nvec + seg * 8), n1 = *(const f32x4*)(nvec + seg * 8 + 4);
          float acc = 0.f;
#pragma unroll
          for (int j = 0; j < 8; ++j) acc = fmaf(bf2f((bf16_t)qq[j]), j < 4 ? n0[j & 3] : n1[j & 3], acc);
          acc = sum8(acc); if (seg == 0) nq[row] = acc; }
        if (c + 1 < NCH) { ML_WRITE(cur ^ 1); if (c + 2 < NCH) ML_LOAD(c + 2); }
        __syncthreads();
#pragma unroll
        for (int ti = 0; ti < 2; ++ti) { const int tl = wave * 2 + ti, tr = tl >> 2, tc = tl & 3; const int r = lane & 15, q = lane >> 4;
            const f32x4 num = mm16(Sb + tr * 16 * LDW, LDW, vT + tc * 16 * LDW, LDW, 64, (f32x4){0.f, 0.f, 0.f, 0.f}, lane);
            const int e = tc * 16 + r;
#pragma unroll
            for (int i = 0; i < 4; ++i) { const int t = tr * 16 + q * 4 + i; const float mm_ = fmaxf(mc, cm[t]); const float cw = fexp(mc - mm_);
                const f32x4 d4 = *(const f32x4*)(den + t * 4);
                const float nn = num[i] + cw * Cq[ti][i], dn = ((d4[0] + d4[1]) + (d4[2] + d4[3])) + cw * nq[t];
                const float hv = nn * __builtin_amdgcn_rcpf(fmaxf(fabsf(dn), fexp(-(cbv[t] + mm_))));
                OUT[((size_t)b * TB + mlstm_pos(dir, c, t)) * 256 + h * 64 + e] = hv; }
            f32x4 cn = Cst[ti] * decay;
            cn = mm16(vT + tr * 16 * LDW, LDW, wkT + tc * 16 * LDW, LDW, 64, cn, lane);
            Cst[ti] = cn;
#pragma unroll
            for (int i = 0; i < 4; ++i) Cb[(tr * 16 + q * 4 + i) * LDW + tc * 16 + r] = f2bf(cn[i]); }
        { const float tot = sum8(wsum_k); if (seg == 0) nvec[row] = decay * nvec[row] + tot; }
        __syncthreads();
    }
#undef ML_LOAD
#undef ML_WRITE
}

template <int L>
__device__ __forceinline__ void hyena_unit(const Frame& F, int l, int c) {
    constexpr bool ISCTX = (L == CTX);
    constexpr int NTT = L >= NTHR ? L / NTHR : 1;
    float* z = (float*)F.lds;
    float* Kf = z + L * 8;
    float* w3c = Kf + 8 * L;
    float* red = w3c + 128;
    int tid = threadIdx.x; asm volatile("" : "+v"(tid)); const int lane = tid & 63, wave = __builtin_amdgcn_readfirstlane(tid >> 6);
    const bf16_t* U = wsp<bf16_t>(F, WS_UH); float* HYO = wsp<float>(F, WS_HYO);
    const float* cw = par(F, PAR_HYCW) + l * 3 * 768; const float* cb = par(F, PAR_HYCB) + l * 768;
    const float* hyt = wsp<float>(F, WS_HYT) + ((size_t)l * 2304 + (ISCTX ? 2048 : 0)) * 64;
    const float* w3 = par(F, PAR_HYW3) + (size_t)l * 64 * 1024;
    const float la = -3.0701134573253945f, lb = -15.350567286626973f;
    const float delta = fabsf(la + (float)c * ((lb - la) / 255.f));
#define TOKB(b) ((size_t)(b) * TB + (ISCTX ? 0 : CTX))
    auto sconv = [&](int col, int b, int t) -> float {
        const bf16_t* up = U + (size_t)col * T + TOKB(b) + t;
        const float u0 = t > 0 ? bf2f(up[-1]) : 0.f, u1 = bf2f(up[0]), u2 = t < L - 1 ? bf2f(up[1]) : 0.f;
        return u0 * cw[col] + u1 * cw[768 + col] + u2 * cw[1536 + col] + cb[col]; };
    for (int i = tid; i < L * 8; i += NTHR) { const int t = i >> 3, b = i & 7; z[i] = sconv(c, b, t); }
    __syncthreads();
    for (int o = 0; o < 2; ++o) {
        if (tid < 128) w3c[tid] = w3[(size_t)(tid & 63) * 1024 + (o * 2 + (tid >> 6)) * 256 + c];
        __syncthreads();
        float ssq = 0.f;
        for (int j = tid; j < L; j += NTHR) { const float* hr = hyt + (size_t)j * 64; float hf = 0.f, hb = 0.f;
#pragma unroll 8
            for (int i = 0; i < 64; ++i) { const float hv = hr[i]; hf = fmaf(hv, w3c[i], hf); hb = fmaf(hv, w3c[64 + i], hb); }
            const float win = expf(-((float)j / (float)(L - 1)) * delta) + 0.05f; hf *= win; hb *= win;
            if (j == 0) { Kf[L] = hf + hb; Kf[0] = 0.f; ssq += (hf + hb) * (hf + hb); }
            else { Kf[L + j] = hf; Kf[L - j] = hb; ssq += hf * hf + hb * hb; } }
        ssq = wsum(ssq, lane); if (lane == 0) red[wave] = ssq;
        __syncthreads();
        float tot = 0.f; for (int i = 0; i < 8; ++i) tot += red[i];
        const float scale = rsqrtf(tot + EPS);
        float acc[NTT][8];
#pragma unroll
        for (int i = 0; i < NTT; ++i)
#pragma unroll
            for (int b = 0; b < 8; ++b) acc[i][b] = 0.f;
        if (tid < L) {
#pragma unroll 2
            for (int s = 0; s < L; ++s) { const f32x4 za = *(const f32x4*)(z + s * 8), zb = *(const f32x4*)(z + s * 8 + 4);
#pragma unroll
                for (int i = 0; i < NTT; ++i) { const float kk = Kf[L + tid + NTHR * i - s];
                    acc[i][0] = fmaf(kk, za[0], acc[i][0]); acc[i][1] = fmaf(kk, za[1], acc[i][1]); acc[i][2] = fmaf(kk, za[2], acc[i][2]); acc[i][3] = fmaf(kk, za[3], acc[i][3]);
                    acc[i][4] = fmaf(kk, zb[0], acc[i][4]); acc[i][5] = fmaf(kk, zb[1], acc[i][5]); acc[i][6] = fmaf(kk, zb[2], acc[i][6]); acc[i][7] = fmaf(kk, zb[3], acc[i][7]); } }
        }
        __syncthreads();
        float* ybuf = Kf;
        if (tid < L) {
#pragma unroll
            for (int i = 0; i < NTT; ++i) { const int t = tid + NTHR * i;
                *(f32x4*)(ybuf + t * 8) = (f32x4){acc[i][0] * scale, acc[i][1] * scale, acc[i][2] * scale, acc[i][3] * scale};
                *(f32x4*)(ybuf + t * 8 + 4) = (f32x4){acc[i][4] * scale, acc[i][5] * scale, acc[i][6] * scale, acc[i][7] * scale}; }
        }
        __syncthreads();
        { const float skip = par(F, PAR_HYSKIP)[(l * 2 + o) * 256 + c];
#pragma unroll 2
          for (int i = tid; i < L * 8; i += NTHR) { const int t = i >> 3, b = i & 7;
              const float r = sconv((o + 1) * 256 + c, b, t) * (ybuf[i] + skip * z[i]);
              if (o == 0) z[i] = r; else HYO[(TOKB(b) + t) * 256 + c] = r; } }
        __syncthreads();
    }
#undef TOKB
}

__device__ __forceinline__ void hyena_mfma_unit(const Frame& F, int l, int c) {
    constexpr int L = SEQ, CPS = 2 * L + 32, OFF = L, ZR = L + 8;
    bf16_t* KC = (bf16_t*)F.lds;
    bf16_t* Z = KC + 8 * CPS;
    bf16_t* X = Z + 8 * ZR;
    float* w3c = (float*)(X + 8 * ZR);
    float* red = w3c + 128;
    int tid = threadIdx.x; asm volatile("" : "+v"(tid)); const int lane = tid & 63, wave = __builtin_amdgcn_readfirstlane(tid >> 6);
    const bf16_t* UH = wsp<bf16_t>(F, WS_UH); float* HYO = wsp<float>(F, WS_HYO);
    const float* cw = par(F, PAR_HYCW) + l * 3 * 768; const float* cb = par(F, PAR_HYCB) + l * 768;
    const float* hyt = wsp<float>(F, WS_HYT) + (size_t)l * 2304 * 64;
    const float* w3 = par(F, PAR_HYW3) + (size_t)l * 64 * 1024;
    const float la = -3.0701134573253945f, lb = -15.350567286626973f;
    const float delta = fabsf(la + (float)c * ((lb - la) / 255.f));
    auto load_conv = [&](int col, bf16_t* dst) {
        const bf16_t* src = UH + (size_t)col * T + CTX;
        const float w0 = cw[col], w1 = cw[768 + col], w2 = cw[1536 + col], bb = cb[col];
        static_assert(8 * (L / 8) == 4 * NTHR, "four items per thread");
        bf16x8 uu[4]; bf16_t um[4], up[4];
#pragma unroll
        for (int k = 0; k < 4; ++k) { const int i = tid + NTHR * k, b = i / (L / 8), t0 = (i % (L / 8)) * 8; const bf16_t* p = src + (size_t)b * TB + t0;
            uu[k] = *(const bf16x8*)p; um[k] = p[t0 > 0 ? -1 : 0]; up[k] = p[t0 + 8 < L ? 8 : 7]; }
#pragma unroll
        for (int k = 0; k < 4; ++k) { const int i = tid + NTHR * k, b = i / (L / 8), t0 = (i % (L / 8)) * 8;
            float x[10]; x[0] = t0 > 0 ? bf2f(um[k]) : 0.f; x[9] = t0 + 8 < L ? bf2f(up[k]) : 0.f;
#pragma unroll
            for (int j = 0; j < 8; ++j) x[1 + j] = bf2f((bf16_t)uu[k][j]);
            float o[8];
#pragma unroll
            for (int j = 0; j < 8; ++j) o[j] = x[j] * w0 + x[j + 1] * w1 + x[j + 2] * w2 + bb;
            u32x4 w = {cvtpk(o[0], o[1]), cvtpk(o[2], o[3]), cvtpk(o[4], o[5]), cvtpk(o[6], o[7])};
            *(u32x4*)(dst + b * ZR + t0) = w; } };
    load_conv(c, Z); load_conv(256 + c, X);
    for (int i = tid; i < 8 * 32; i += NTHR) { const int a = i >> 5, k = i & 31;
        if (k <= a) KC[a * CPS + k] = 0; if (k < 32 - a) KC[a * CPS + 2 * L + a + k] = 0; }
    const int r = lane & 31, g = lane >> 5, blk = r >> 3, bb_ = r & 7;
    const bf16_t* arow = KC + (r & 7) * CPS + OFF + 8 * g - 8 * (r >> 3);
    const bf16_t* zrow = Z + bb_ * ZR + 8 * g;
    const int tb0 = 256 * wave + 32 * blk, tb1 = tb0 + 128;
    f32x16 y0, y1;
    for (int o = 0; o < 2; ++o) {
        __syncthreads();
        float ssq = 0.f;
        {
            const float* kfb = wsp<float>(F, WS_KF) + ((size_t)(l * 2 + o) * 256) * 4096; const float* kf = kfb + kf_off(c, tid * 8);
            const f32x4 k0 = *(const f32x4*)kf, k1 = *(const f32x4*)(kf + 4); const float hb0 = kfb[kf_off(c, 0)];
            float kv[8] = {k0[0], k0[1], k0[2], k0[3], k1[0], k1[1], k1[2], k1[3]};
#pragma unroll
            for (int j = 0; j < 8; ++j) { const int idx = tid * 8 + j; float v = kv[j];
                if (idx == 0) continue;
                if (idx == L) v += hb0;
                ssq += v * v; const bf16_t vb = f2bf(v); const int d = idx - L;
#pragma unroll
                for (int a = 0; a < 8; ++a) KC[a * CPS + OFF + a - d] = vb; } }
        ssq = wsum(ssq, lane); if (lane == 0) red[wave] = ssq;
        __syncthreads();
        float tot = 0.f; for (int i = 0; i < 8; ++i) tot += red[i];
        const float scale = rsqrtf(tot + EPS);
        y0 = f32x16{}; y1 = f32x16{};
        const int Dlo = 256 * wave - (L - 16), Dhi = 256 * wave + 224;
#define HY_LOAD(AF, B0, B1, DD) do { AF = *(const bf16x8*)(arow - (DD)); const int _s0 = tb0 - (DD), _s1 = tb1 - (DD); \
            B0 = *(const bf16x8*)(zrow + min(max(_s0, 0), L - 16)); B1 = *(const bf16x8*)(zrow + min(max(_s1, 0), L - 16)); \
            if ((unsigned)_s0 >= (unsigned)L) B0 = bf16x8{}; if ((unsigned)_s1 >= (unsigned)L) B1 = bf16x8{}; } while (0)
        bf16x8 afA, b0A, b1A, afB, b0B, b1B;
        HY_LOAD(afA, b0A, b1A, Dlo);
#pragma unroll 1
        for (int Dd = Dlo; Dd <= Dhi; Dd += 32) {
            HY_LOAD(afB, b0B, b1B, Dd + 16);
            y0 = __builtin_amdgcn_mfma_f32_32x32x16_bf16(afA, b0A, y0, 0, 0, 0);
            y1 = __builtin_amdgcn_mfma_f32_32x32x16_bf16(afA, b1A, y1, 0, 0, 0);
            HY_LOAD(afA, b0A, b1A, min(Dd + 32, Dhi));
            y0 = __builtin_amdgcn_mfma_f32_32x32x16_bf16(afB, b0B, y0, 0, 0, 0);
            y1 = __builtin_amdgcn_mfma_f32_32x32x16_bf16(afB, b1B, y1, 0, 0, 0); }
#undef HY_LOAD
        asm volatile("s_nop 15\n\ts_nop 15" : "+v"(y0), "+v"(y1));
        const float skip = par(F, PAR_HYSKIP)[(l * 2 + o) * 256 + c];
        float res[2][16];
#pragma unroll
        for (int nt = 0; nt < 2; ++nt)
#pragma unroll
        for (int rq = 0; rq < 4; ++rq) { const int t4 = (nt ? tb1 : tb0) + 8 * rq + 4 * g;
            const u32x2 xw = *(const u32x2*)(X + bb_ * ZR + t4), zw = *(const u32x2*)(Z + bb_ * ZR + t4);
            const float xv[4] = {__uint_as_float(xw[0] << 16), __uint_as_float(xw[0] & 0xffff0000u), __uint_as_float(xw[1] << 16), __uint_as_float(xw[1] & 0xffff0000u)};
            const float zv[4] = {__uint_as_float(zw[0] << 16), __uint_as_float(zw[0] & 0xffff0000u), __uint_as_float(zw[1] << 16), __uint_as_float(zw[1] & 0xffff0000u)};
#pragma unroll
            for (int k = 0; k < 4; ++k) res[nt][rq * 4 + k] = xv[k] * ((nt ? y1[rq * 4 + k] : y0[rq * 4 + k]) * scale + skip * zv[k]); }
        __syncthreads();
        if (o == 0) {
#pragma unroll
            for (int nt = 0; nt < 2; ++nt)
#pragma unroll
            for (int rq = 0; rq < 4; ++rq) { const int t4 = (nt ? tb1 : tb0) + 8 * rq + 4 * g;
                u32x2 w = {cvtpk(res[nt][rq * 4], res[nt][rq * 4 + 1]), cvtpk(res[nt][rq * 4 + 2], res[nt][rq * 4 + 3])};
                *(u32x2*)(Z + bb_ * ZR + t4) = w; }
            load_conv(512 + c, X);
        } else {
#pragma unroll
            for (int nt = 0; nt < 2; ++nt)
#pragma unroll
            for (int rq = 0; rq < 4; ++rq) { const int t4 = (nt ? tb1 : tb0) + 8 * rq + 4 * g;
#pragma unroll
                for (int k = 0; k < 4; ++k) HYO[((size_t)bb_ * TB + CTX + t4 + k) * 256 + c] = res[nt][rq * 4 + k]; }
        }
    }
    __syncthreads();
}

__device__ __forceinline__ void phase_mlstm_only(const Frame& F0, int l) {
    const Frame F = phase_frame(F0);
    for (int v = (F.bid + 131) % F.G; v < 64; v += F.G) mlstm_unit(F, l, v >> 3, (v >> 1) & 3, v & 1);
}
__device__ __forceinline__ void phase_mixers(const Frame& F0, int l) {
    const Frame F = phase_frame(F0);
    constexpr int N_ML = 64, N_AT = 512, N_HL = 256, N_AC = 64, N_HC = 256, NMIX = N_ML + N_AT + N_HL + N_AC + N_HC, NCVT = NE * 6, NTOT = NMIX + NCVT;
    static_assert(NMIX == 384 * 3 && NCVT == 384 * 4, "queue interleave: 384 groups of 3 mixer units + 3 conversion slots, then 384 trailing conversion slots (short jobs fill the phase's tail)");
    unsigned* head = (unsigned*)(F.ws + CTL_WQ) + 64 * l;
    volatile int* slot = (volatile int*)(F.lds + LDS_BYTES - 32);
#ifndef MIXMASK
#define MIXMASK 31
#endif
#ifndef MIXREP
#define MIXREP 0
#endif
    for (;;) {
        if (F.tid == 0) { const int v0 = (int)__hip_atomic_fetch_add(head, 1u, __ATOMIC_RELAXED, __HIP_MEMORY_SCOPE_AGENT); slot[0] = v0;
            if (v0 < NTOT && (v0 >= 384 * 6 || v0 % 6 >= 3)) slot[1] = (int)__hip_atomic_fetch_add(head + 64 * 2, 1u, __ATOMIC_RELAXED, __HIP_MEMORY_SCOPE_AGENT); }
        __syncthreads();
        int v = slot[0]; const int cj = slot[1];
        __syncthreads();
        if (v >= NTOT) break;
        { const int grp = v / 6, w = v % 6; if (v >= 384 * 6 || w >= 3) { if (cj < NCVTJ) { expert_cvt_job(F, l, cj); if (MIXREP & 8) expert_cvt_job(F, l, cj); } continue; } v = grp * 3 + w; }
        if (v < N_ML) { if (MIXMASK & 4) { mlstm_unit(F, l, v >> 3, (v >> 1) & 3, v & 1); if (MIXREP & 2) mlstm_unit(F, l, v >> 3, (v >> 1) & 3, v & 1); } continue; } v -= N_ML;
        if (v < N_AT) { if (MIXMASK & 2) { attn_unit(F, l, v >> 6, (v >> 3) & 7, v & 7); if (MIXREP & 1) attn_unit(F, l, v >> 6, (v >> 3) & 7, v & 7); } continue; } v -= N_AT;
        if (v < N_HL) { if (MIXMASK & 1) { hyena_mfma_unit(F, l, v); if (MIXREP & 4) hyena_mfma_unit(F, l, v); } continue; } v -= N_HL;
        if (l == 1) continue;
        if (v < N_AC) { if (MIXMASK & 8) attn_unit(F, l, v >> 3, v & 7, 8); continue; } v -= N_AC;
        if (MIXMASK & 16) hyena_unit<CTX>(F, l, v);
    }
}

__device__ __forceinline__ void phase_finish(const Frame& F0, int l) {
    const Frame F = phase_frame(F0);
    const int lane = F.lane;
    const float* lp = par(F, PAR_DALAM) + l * 256;
    const float la = wsum(lp[lane] * lp[64 + lane], lane), lb = wsum(lp[128 + lane] * lp[192 + lane], lane);
    const float lam_init = 0.8f - 0.6f * expf(-0.3f * (float)l);
    const float lam = expf(la) - expf(lb) + lam_init;
    const float* HF = wsp<float>(F, WS_HF); const float* HB = wsp<float>(F, WS_HB); const float* O = wsp<float>(F, WS_O);
    const bf16_t* U = wsp<bf16_t>(F, WS_U); bf16_t* MIX = wsp<bf16_t>(F, WS_MIX); const float* HYO = wsp<float>(F, WS_HYO);
    const f32x4 mg = *(const f32x4*)(par(F, PAR_MLNG) + l * 256 + 4 * lane);
    const float sg0 = par(F, PAR_DASUB)[l * 128 + 2 * lane] * (1.f - lam_init), sg1 = par(F, PAR_DASUB)[l * 128 + 2 * lane + 1] * (1.f - lam_init);
    typedef float f32x2 __attribute__((ext_vector_type(2)));
    for (int t = F.bid * 8 + F.wave; t < T; t += F.G * 8) {
        if (l == 1 && t % TB < CTX) continue;
        const f32x4 hf = *(const f32x4*)(HF + (size_t)t * 256 + 4 * lane), hb = *(const f32x4*)(HB + (size_t)t * 256 + 4 * lane);
        const u32x2 ow = *(const u32x2*)(U + (size_t)t * NU + 768 + 4 * lane);
        const f32x4 hy = *(const f32x4*)(HYO + (size_t)t * 256 + 4 * lane);
        f32x2 oa[4], ob[4];
#pragma unroll
        for (int h = 0; h < 4; ++h) { const float* op = O + (size_t)t * 1024 + h * 256 + 2 * lane; oa[h] = *(const f32x2*)op; ob[h] = *(const f32x2*)(op + 128); }
        const f32x4 hv = hf + hb;
        float d0[4], d1[4], sq[4];
#pragma unroll
        for (int h = 0; h < 4; ++h) { d0[h] = oa[h][0] - lam * ob[h][0]; d1[h] = oa[h][1] - lam * ob[h][1]; sq[h] = d0[h] * d0[h] + d1[h] * d1[h]; }
#pragma unroll
        for (int o = 32; o >= 1; o >>= 1) {
#pragma unroll
            for (int h = 0; h < 4; ++h) sq[h] += shx(sq[h], o, lane); }
        {
          float s16 = hv[0] * hv[0] + hv[1] * hv[1] + hv[2] * hv[2] + hv[3] * hv[3];
          s16 += shx(s16, 1, lane); s16 += shx(s16, 2, lane); s16 += shx(s16, 4, lane); s16 += shx(s16, 8, lane);
          const float rr = rsqrtf(s16 * (1.f / 64.f) + EPS);
          const float o0 = __uint_as_float(ow[0] << 16), o1 = __uint_as_float(ow[0] & 0xffff0000u), o2 = __uint_as_float(ow[1] << 16), o3 = __uint_as_float(ow[1] & 0xffff0000u);
          const float y0 = sigmoidf_(o0) * (hv[0] * rr * mg[0]), y1 = sigmoidf_(o1) * (hv[1] * rr * mg[1]), y2 = sigmoidf_(o2) * (hv[2] * rr * mg[2]), y3 = sigmoidf_(o3) * (hv[3] * rr * mg[3]);
          u32x2 w = {cvtpk(y0, y1), cvtpk(y2, y3)};
          *(u32x2*)(MIX + (size_t)t * 1024 + 4 * lane) = w;
          u32x2 wy = {cvtpk(hy[0], hy[1]), cvtpk(hy[2], hy[3])};
          *(u32x2*)(MIX + (size_t)t * 1024 + 768 + 4 * lane) = wy; }
#pragma unroll
        for (int h = 0; h < 4; ++h) { const float rr = rsqrtf(sq[h] * (1.f / 128.f) + EPS);
            *(unsigned*)(MIX + (size_t)t * 1024 + 256 + h * 128 + 2 * lane) = cvtpk(d0[h] * rr * sg0, d1[h] * rr * sg1); }
    }
}

__device__ __forceinline__ void phase_norm2(const Frame& F0, int l) {
    const Frame F = phase_frame(F0);
    const int lane = F.lane;
    const float* XL = wsp<float>(F, WS_XL); bf16_t* H2X = wsp<bf16_t>(F, WS_H2X); const float* modv = wsp<float>(F, WS_MODV); const float* ng = par(F, PAR_N2G) + l * 1024;
    for (int t = F.bid * 8 + F.wave; t < T; t += F.G * 8) { const int b = t / TB, p = t % TB; const int mrow = p < CTX ? 8 : b;
        if (l == 1 && p < CTX) continue;
        const float* mv = modv + ((size_t)l * 9 + mrow) * 6144 + 3 * 1024;
        f32x4 xv[4]; float ss = 0.f;
#pragma unroll
        for (int i = 0; i < 4; ++i) { xv[i] = *(const f32x4*)(XL + (size_t)t * D + 4 * lane + 256 * i); ss += xv[i][0] * xv[i][0] + xv[i][1] * xv[i][1] + xv[i][2] * xv[i][2] + xv[i][3] * xv[i][3]; }
        ss = wsum(ss, lane); const float rr = rsqrtf(ss * (1.f / 1024.f) + EPS);
#pragma unroll
        for (int i = 0; i < 4; ++i) { const int k = 4 * lane + 256 * i;
            const f32x4 g = *(const f32x4*)(ng + k), sh = *(const f32x4*)(mv + k), sc = *(const f32x4*)(mv + 1024 + k);
            const f32x4 hv = (xv[i] * rr) * g * (sc + 1.f) + sh;
            const unsigned h01 = cvtpk(hv[0], hv[1]), h23 = cvtpk(hv[2], hv[3]);
            const float l0 = hv[0] - __uint_as_float(h01 << 16), l1 = hv[1] - __uint_as_float(h01 & 0xffff0000u), l2 = hv[2] - __uint_as_float(h23 << 16), l3 = hv[3] - __uint_as_float(h23 & 0xffff0000u);
            u32x2 wh = {h01, h23}, wl = {cvtpk(l0, l1), cvtpk(l2, l3)};
            *(u32x2*)(H2X + (size_t)t * 2048 + k) = wh; *(u32x2*)(H2X + (size_t)t * 2048 + 1024 + k) = wl; } }
}
__device__ __forceinline__ void phase_rgemm(const Frame& F0, int l) {
    const Frame F = phase_frame(F0);
    const bf16_t* A = wsp<bf16_t>(F, WS_H2X); const bf16_t* W = wsp<bf16_t>(F, WS_WR) + (size_t)l * 256 * 3072; float* LOG = wsp<float>(F, WS_LOG);
    bf16_t* GSH = wsp<bf16_t>(F, WS_GSH); const bf16_t* WS = wsp<bf16_t>(F, WS_WSH13) + (size_t)l * 512 * 1024;
    const int xl = F.bid & 7, rk = F.bid >> 3, nr = F.G >> 3, npan = l == 1 ? 8 : 9;
    const bool split = nr > npan;
    if (!split || rk < npan) {
        gemm_stream(rk, split ? npan : nr, npan,
            [&](int j) { return g8::GU{A, W, label_panel(xl, j) * 256, 0, 0}; },
            [&](int j, int jn, const g8::GU& cur, bool pf, bool hn, const g8::GU& nx) -> bool { EpiStoreF32 E{LOG + (size_t)label_panel(xl, j) * 256 * 256, 256}; g8::gemm256<false, 32, true, 1, 32>(F.lds, cur, 2048, 3072, E, pf, hn, nx); return hn; });
        __syncthreads(); }
    if (!split || rk >= npan) {
        gemm_stream(split ? rk - npan : rk, split ? nr - npan : nr, npan * 2,
            [&](int v) { const int pan = label_panel(xl, v >> 1), p = v & 1; return g8::GU{A, WS + (size_t)p * 256 * 1024, pan * 256, 0, 0}; },
            [&](int v, int jn, const g8::GU& cur, bool pf, bool hn, const g8::GU& nx) -> bool { const int pan = label_panel(xl, v >> 1), p = v & 1; EpiSwiGLU E{GSH + (size_t)pan * 256 * 256 + p * 128};
                g8::gemm256<false, 0, true, 1, 8>(F.lds, cur, 2048, 1024, E, pf, hn, nx); return hn; });
        __syncthreads();
        if (split && l == 0) if (rk - npan >= npan * 2) cvt_pull(F0, 1, 3); }
}
__device__ __forceinline__ void phase_topk(const Frame& F0, int l) {
    const Frame F = phase_frame(F0);
    const int lane = F.lane;
    const float* LOG = wsp<float>(F, WS_LOG); int* EIDX = wsp<int>(F, WS_EIDX); float* WSLOT = wsp<float>(F, WS_WSLOT);
    const f32x4 rbv = *(const f32x4*)(par(F, PAR_RB) + l * 256 + 4 * lane);
    int* hist = (int*)F.lds;
    if (F.tid < NE) hist[F.tid] = 0;
    __syncthreads();
    const int segt = (T + F.G - 1) / F.G, t0 = F.bid * segt;
    constexpr int NTK = 3;
    for (int i0 = F.wave; i0 < segt; i0 += 8 * NTK) {
        int tt[NTK]; bool act[NTK]; f32x4 lgv[NTK];
#pragma unroll
        for (int u = 0; u < NTK; ++u) { const int i = i0 + 8 * u, t = t0 + i; act[u] = i < segt && t < T; tt[u] = act[u] ? t : t0;
            if (act[u] && l == 1 && t % TB < CTX) { if (lane < 8) EIDX[(size_t)t * 8 + lane] = -1; act[u] = false; }
            lgv[u] = *(const f32x4*)(LOG + (size_t)tt[u] * 256 + 4 * lane); }
        float sc[NTK][4], sel[NTK][4], m1[NTK], m2[NTK];
#pragma unroll
        for (int u = 0; u < NTK; ++u) {
#pragma unroll
            for (int j = 0; j < 4; ++j) { sc[u][j] = 1.f / (1.f + expf(-lgv[u][j])); sel[u][j] = sc[u][j] + rbv[j]; }
            m1[u] = -INFINITY; m2[u] = -INFINITY;
#pragma unroll
            for (int j = 0; j < 4; ++j) { const float v = sel[u][j]; if (v > m1[u]) { m2[u] = m1[u]; m1[u] = v; } else if (v > m2[u]) m2[u] = v; } }
#pragma unroll
        for (int off = 1; off <= 4; off <<= 1) {
#pragma unroll
            for (int u = 0; u < NTK; ++u) { const float o1 = shx(m1[u], off, lane), o2 = shx(m2[u], off, lane);
                const float n1 = fmaxf(m1[u], o1), n2 = fmaxf(fminf(m1[u], o1), fmaxf(m2[u], o2)); m1[u] = n1; m2[u] = n2; } }
        const int g = lane >> 3; int rank[NTK]; float gs[NTK];
#pragma unroll
        for (int u = 0; u < NTK; ++u) { gs[u] = m1[u] + m2[u]; rank[u] = 0; }
#pragma unroll
        for (int gp = 0; gp < 8; ++gp) {
#pragma unroll
            for (int u = 0; u < NTK; ++u) { const float s2 = shi(gs[u], gp * 8); rank[u] += (s2 > gs[u] || (s2 == gs[u] && gp < g)) ? 1 : 0; } }
#pragma unroll
        for (int u = 0; u < NTK; ++u) if (rank[u] >= 4) {
#pragma unroll
            for (int j = 0; j < 4; ++j) sel[u][j] = -INFINITY; }
        int myidx[NTK]; float myw[NTK], wtot[NTK];
#pragma unroll
        for (int u = 0; u < NTK; ++u) { myidx[u] = 0; myw[u] = 0.f; wtot[u] = 0.f; }
#pragma unroll 1
        for (int k = 0; k < 8; ++k) { float bv[NTK]; int bi[NTK];
#pragma unroll
            for (int u = 0; u < NTK; ++u) { bv[u] = sel[u][0]; bi[u] = lane * 4;
#pragma unroll
                for (int j = 1; j < 4; ++j) if (sel[u][j] > bv[u]) { bv[u] = sel[u][j]; bi[u] = lane * 4 + j; } }
#pragma unroll
            for (int off = 32; off >= 1; off >>= 1) {
#pragma unroll
                for (int u = 0; u < NTK; ++u) { const float ov = shx(bv[u], off, lane); const int oi = shx(bi[u], off, lane); if (ov > bv[u] || (ov == bv[u] && oi < bi[u])) { bv[u] = ov; bi[u] = oi; } } }
            float wsc[NTK];
#pragma unroll
            for (int u = 0; u < NTK; ++u) { const bool own = (bi[u] >> 2) == lane; const int jj = bi[u] & 3; wsc[u] = 0.f;
#pragma unroll
                for (int j = 0; j < 4; ++j) if (own && jj == j) { wsc[u] = sc[u][j]; sel[u][j] = -INFINITY; } }
#pragma unroll
            for (int u = 0; u < NTK; ++u) { wsc[u] = shi(wsc[u], bi[u] >> 2); wtot[u] += wsc[u]; if (lane == k) { myidx[u] = bi[u]; myw[u] = wsc[u]; } } }
#pragma unroll
        for (int u = 0; u < NTK; ++u) { const float w = myw[u] / wtot[u] * 2.5f;
            if (act[u] && lane < 8) { EIDX[(size_t)tt[u] * 8 + lane] = myidx[u]; WSLOT[(size_t)tt[u] * 8 + lane] = w; atomicAdd(&hist[myidx[u]], 1); } }
    }
    __syncthreads();
    if (F.tid < NE) wsp<int>(F, WS_HIST)[F.bid * NE + F.tid] = hist[F.tid];
}

__device__ __forceinline__ void phase_lists(const Frame& F0, int l) {
    const Frame F = phase_frame(F0);
    int* base = (int*)F.lds; int* part = base + NE; int* sege = part + NE; constexpr int MAXS = 2304;
    const int* EIDX = wsp<int>(F, WS_EIDX); const float* WSLOT = wsp<float>(F, WS_WSLOT); const int* HIST = wsp<int>(F, WS_HIST); int* LIST = wsp<int>(F, WS_LIST);
    const int segt = (T + F.G - 1) / F.G, s0 = F.bid * segt * 8, ns = max(0, min(segt * 8, T * 8 - s0));
    const int e = F.tid & 255, half = F.tid >> 8;
    int acc = 0;
#pragma unroll 8
    for (int b = half; b < F.bid; b += 2) acc += HIST[b * NE + e];
    if (half) part[e] = acc;
    for (int i = F.tid; i < ns; i += NTHR) sege[i] = EIDX[s0 + i];
    __syncthreads();
    if (!half) { acc += part[e]; base[e] = acc; if (F.bid == F.G - 1) ((int*)(F.ws + CTL_CNT))[l * 256 + e] = acc + HIST[F.bid * NE + e]; }
    __syncthreads();
    for (int i = F.tid; i < ns; i += NTHR) { const int me = sege[i]; if (me < 0) continue;
        int rank = 0;
        for (int j = (i & ~7) - 8; j >= 0; j -= 8) {
            const i32x4 a = *(const i32x4*)(sege + j), c = *(const i32x4*)(sege + j + 4);
            rank += (a[0] == me) + (a[1] == me) + (a[2] == me) + (a[3] == me) + (c[0] == me) + (c[1] == me) + (c[2] == me) + (c[3] == me); }
        i32x2 o = {s0 + i, __float_as_int(WSLOT[s0 + i])}; *(i32x2*)(LIST + 2 * ((size_t)me * T + base[me] + rank)) = o; }
}

__device__ __forceinline__ void moe_prefix(const Frame& F, int l, int* pre) {
    const int* cnt = (const int*)(F.ws + CTL_CNT) + l * 256;
    int* nb = pre + NE + 8;
    if (F.tid < NE) nb[F.tid] = (cnt[(F.tid & 31) * 8 + (F.tid >> 5)] + 255) >> 8;
    __syncthreads();
    if (F.tid <= NE) { int sum = 0; for (int j = 0; j < F.tid; ++j) sum += nb[j]; pre[F.tid] = sum; }
    __syncthreads();
}
__device__ __forceinline__ int moe_find(const int* pre, int q) { int lo = 0, hi = NE; while (hi - lo > 1) { const int mid = (lo + hi) >> 1; if (__builtin_amdgcn_readfirstlane(pre[mid]) <= q) lo = mid; else hi = mid; } return __builtin_amdgcn_readfirstlane(lo); }
#define RFL(x) __builtin_amdgcn_readfirstlane(x)

__device__ __forceinline__ void phase_moe1(const Frame& F0, int l) {
    const Frame F = phase_frame(F0);
    int* pre = (int*)(F.lds + 131072);
    moe_prefix(F, l, pre);
    const int nexp = RFL(pre[NE]); const int* cnt = (const int*)(F.ws + CTL_CNT) + l * 256; const int* LIST = wsp<int>(F, WS_LIST);
    const bf16_t* H = wsp<bf16_t>(F, WS_H2X); bf16_t* G = wsp<bf16_t>(F, WS_G); bf16_t* GSH = wsp<bf16_t>(F, WS_GSH);
    const bf16_t* WE = wsp<bf16_t>(F, WS_WE13) + (size_t)l * NE * 512 * 1024; const bf16_t* WS = wsp<bf16_t>(F, WS_WSH13) + (size_t)l * 512 * 1024;
    const int xl = F.bid & 7, rk = F.bid >> 3, nr = F.G >> 3; const int q0 = RFL(pre[32 * xl]), nq = RFL(pre[32 * xl + 32]) - q0;
    gemm_stream(rk, nr, nq * 2,
        [&](int j) { const int q = q0 + (j >> 1), p = j & 1; const int ei = moe_find(pre, q); const int e = (ei & 31) * 8 + (ei >> 5); const int pe = RFL(pre[ei]); const int rb = q - pe, c = RFL(cnt[e]); const int* le = LIST + (size_t)e * T * 2;
            int tz = threadIdx.x; asm volatile("" : "+v"(tz)); const int r0 = g8::stage_row(tz, 0), r1 = g8::stage_row(tz, 1);
            const int p00 = min(rb * 256 + r0, c - 1), p01 = min(rb * 256 + r1, c - 1), p10 = min(rb * 256 + 128 + r0, c - 1), p11 = min(rb * 256 + 128 + r1, c - 1);
            return g8::GU{H, WE + ((size_t)e * 512 + p * 256) * 1024, 0, (le[2 * p00] >> 3) | ((le[2 * p01] >> 3) << 16), (le[2 * p10] >> 3) | ((le[2 * p11] >> 3) << 16)}; },
        [&](int j, int jn, const g8::GU& cur, bool pf, bool hn, const g8::GU& nx) -> bool { const int q = q0 + (j >> 1), p = j & 1;
            EpiSwiGLU E{G + (size_t)q * 256 * 256 + p * 128};
            g8::gemm256<true, 0, true, 1, 8>(F.lds, cur, 2048, 1024, E, pf, hn, nx); return hn; });
    __syncthreads();
}
__device__ __forceinline__ void phase_moe2(const Frame& F0, int l) {
    const Frame F = phase_frame(F0);
    int* pre = (int*)(F.lds + 131072);
    moe_prefix(F, l, pre);
    const int nexp = RFL(pre[NE]); const int* cnt = (const int*)(F.ws + CTL_CNT) + l * 256; const int* LIST = wsp<int>(F, WS_LIST); const float* WSLOT = wsp<float>(F, WS_WSLOT);
    const bf16_t* G = wsp<bf16_t>(F, WS_G); const bf16_t* GSH = wsp<bf16_t>(F, WS_GSH); bf16_t* Y = wsp<bf16_t>(F, WS_Y); bf16_t* YSH = wsp<bf16_t>(F, WS_YSH);
    const bf16_t* WE = wsp<bf16_t>(F, WS_WE2) + (size_t)l * NE * 1024 * 256; const bf16_t* WS = wsp<bf16_t>(F, WS_WSH2) + (size_t)l * 1024 * 256;
    const int xl = F.bid & 7, rk = F.bid >> 3, nr = F.G >> 3; const int q0 = RFL(pre[32 * xl]), nq = RFL(pre[32 * xl + 32]) - q0;
    const int ntot = nq * 4 + (l == 1 ? 8 : 9) * 4;
    gemm_stream(rk, nr, ntot,
        [&](int j) { if (j < nq * 4) { const int q = q0 + (j >> 2), ct = j & 3; const int ei = moe_find(pre, q); const int e = (ei & 31) * 8 + (ei >> 5);
                return g8::GU{G, WE + ((size_t)e * 1024 + ct * 256) * 256, q * 256, 0, 0}; }
            const int v = j - nq * 4, pan = label_panel(xl, v >> 2), ct = v & 3; return g8::GU{GSH, WS + (size_t)ct * 256 * 256, pan * 256, 0, 0}; },
        [&](int j, int jn, const g8::GU& cur, bool pf, bool hn, const g8::GU& nx) -> bool {
            if (j < nq * 4) { const int q = q0 + (j >> 2), ct = j & 3; const int ei = moe_find(pre, q); const int e = (ei & 31) * 8 + (ei >> 5); const int rb = q - RFL(pre[ei]);
                EpiScatterY E{Y + ct * 256, LIST + (size_t)e * T * 2, RFL(cnt[e]), rb * 256, T * 8 + F.bid};
                g8::gemm256<false, 0, true, 1, 16>(F.lds, cur, 256, 256, E, pf, hn, nx); }
            else { const int v = j - nq * 4, pan = label_panel(xl, v >> 2), ct = v & 3; EpiStoreBf16 E{YSH + (size_t)pan * 256 * 1024 + ct * 256, 1024};
                g8::gemm256<false, 0, true, 1, 16>(F.lds, cur, 256, 256, E, pf, hn, nx); } return hn; });
    __syncthreads();
}

#ifndef MK_DEBUG
#define MK_DEBUG 0
#endif
constexpr size_t CTL_DBG = CTL_CNT + 2 * 256 * 4;
__device__ __forceinline__ void dbg_checksum(const Frame& F0, size_t off, size_t nbytes, int slot) {
    const Frame F = phase_frame(F0);
    const unsigned* p = (const unsigned*)(F.ws + off); const size_t n = nbytes / 4;
    unsigned long long s = 0;
    for (size_t i = (size_t)F.bid * NTHR + F.tid; i < n; i += (size_t)F.G * NTHR) s += (unsigned long long)p[i] * (unsigned long long)((unsigned)i * 2654435761u + 12345u);
    for (int o = 32; o >= 1; o >>= 1) { const unsigned lo = shx((int)(unsigned)s, o, F.lane), hi = shx((int)(unsigned)(s >> 32), o, F.lane); s += ((unsigned long long)hi << 32) | lo; }
    if (F.lane == 0) atomicAdd((unsigned long long*)(F.ws + CTL_DBG) + slot, s);
}
constexpr int NPH = 26;
__global__ void __launch_bounds__(NTHR, 2) fwd(Args a) {
    extern __shared__ __attribute__((aligned(16))) unsigned char lds[];
    Frame F;
    F.x = a.in[I_X]; F.ctx = a.in[I_CTX]; F.ew1 = a.in[I_EW1]; F.ew3 = a.in[I_EW3]; F.ew2 = a.in[I_EW2]; F.out = a.out; F.ws = a.ws; F.lds = (char*)lds;
    F.tid = threadIdx.x; F.lane = F.tid & 63; F.wave = __builtin_amdgcn_readfirstlane(F.tid >> 6); F.G = gridDim.x; F.bid = blockIdx.x;
    const int lo = a.ph_lo, hi = a.ph_hi;
    volatile LAS unsigned* st = (volatile LAS unsigned*)(LAS unsigned char*)(lds + LDS_BYTES - 16);
    XcdBarrier bar; bar.bar = (unsigned*)(a.ws + WS_CTL); bar.x = 0; bar.st = st;
    if (hi - lo > 1) {
        if (F.tid == 0) { st[0] = 0u; st[1] = 0u; }
        __syncthreads();
        bar = xcd_barrier_post((unsigned*)(a.ws + WS_CTL), st);
    }
#ifndef PHMASK
#define PHMASK 0xfff
#endif
#define ON(j) ((PHMASK >> (j)) & 1)
#ifndef REPMASK
#define REPMASK 0
#endif
#define REP(j) ((REPMASK >> (j)) & 1)
#ifndef MK_POISON
#define MK_POISON 0
#endif
#define LDS_NAN() do { if (MK_POISON) { __syncthreads(); for (int _i = F.tid; _i < (LDS_BYTES - 16) / 4; _i += NTHR) ((unsigned*)lds)[_i] = 0xFFFFFFFFu; __syncthreads(); } } while (0)
#define IN(k) (lo <= (k) && (k) < hi)
#define SEAM(k) do { if (IN(k) && IN((k) + 1)) { xcd_barrier(bar); LDS_NAN(); } } while (0)
#if MK_DEBUG == 2
#define XCS(id, sums) do { xcd_barrier(bar); { const int _s = (id); sums } } while (0)
#else
#define XCS(id, sums) do { } while (0)
#endif
#define CS(off, bytes) dbg_checksum(F, off, bytes, _s);
#if MK_POISON
    { u32x4* w = (u32x4*)(a.ws + WS_MODV); const size_t n = (WS_END - WS_MODV) / 16; const u32x4 nanv = {0xFFFFFFFFu, 0xFFFFFFFFu, 0xFFFFFFFFu, 0xFFFFFFFFu};
      for (size_t i = (size_t)F.bid * NTHR + F.tid; i < n; i += (size_t)F.G * NTHR) w[i] = nanv;
      xcd_barrier(bar); LDS_NAN(); }
#endif
    if (ON(0) && IN(0)) { phase_prologue(F, a); if (REP(0)) { xcd_barrier(bar); phase_prologue(F, a); } }
    SEAM(0);
    XCS(1, CS(WS_MODV, (size_t)(WS_WE13 - WS_MODV)) CS(WS_WE13, (size_t)64 << 20) CS(WS_WE2, (size_t)64 << 20));
#if MK_DEBUG == 1
#define DBGRUN(id, call, sums) do { call; xcd_barrier(bar); { const int _s = 2 * (id); sums } xcd_barrier(bar); call; xcd_barrier(bar); { const int _s = 2 * (id) + 1; sums } xcd_barrier(bar); } while (0)
#else
#define DBGRUN(id, call, sums) do { call; } while (0)
#endif
#define LAYER(l) do { constexpr int pb = 1 + 12 * (l); \
        if (ON(1) && IN(pb + 0)) phase_norm1(F, l); \
        XCS(2 + 14 * (l), CS(WS_XL, (size_t)T * D * 4) CS(WS_H, (size_t)T * D * 2) CS(WS_GATE + (size_t)(l) * T * 16 * 4, (size_t)T * 16 * 4)); \
        SEAM(pb + 0); \
        if (ON(2) && IN(pb + 1)) DBGRUN(10 * (l) + 0, phase_gemm_in(F, l), CS(WS_U, USZ)); \
        if (REP(2)) { xcd_barrier(bar); phase_gemm_in(F, l); } \
        XCS(3 + 14 * (l), CS(WS_U, USZ)); \
        SEAM(pb + 1); \
        if (ON(4) && IN(pb + 3)) DBGRUN(10 * (l) + 2, phase_mixers(F, l), CS(WS_O, (size_t)T * D * 4) CS(WS_HF, (size_t)T * 256 * 4) CS(WS_HB, (size_t)T * 256 * 4) CS(WS_HYO, (size_t)T * 256 * 4)); \
        if (REP(4)) { xcd_barrier(bar); if (F.bid == 0 && F.tid == 0) __hip_atomic_store((unsigned*)(a.ws + CTL_WQ) + 64 * (l), 0u, __ATOMIC_RELAXED, __HIP_MEMORY_SCOPE_AGENT); xcd_barrier(bar); phase_mixers(F, l); } \
        XCS(5 + 14 * (l), CS(WS_O, (size_t)T * D * 4)); XCS(6 + 14 * (l), CS(WS_HF, (size_t)T * 256 * 4) CS(WS_HB, (size_t)T * 256 * 4)); XCS(7 + 14 * (l), CS(WS_HYO, (size_t)T * 256 * 4)); \
        if (MK_DEBUG == 3) { xcd_barrier(bar); { const int _s = 4 * (l); CS(WS_HF, (size_t)T * 256 * 4) CS(WS_HB, (size_t)T * 256 * 4) } xcd_barrier(bar); phase_mlstm_only(F, l); xcd_barrier(bar); { const int _s = 4 * (l) + 1; CS(WS_HF, (size_t)T * 256 * 4) CS(WS_HB, (size_t)T * 256 * 4) } } \
        SEAM(pb + 3); \
        if (ON(5) && IN(pb + 4)) DBGRUN(10 * (l) + 3, phase_finish(F, l), CS(WS_MIX, (size_t)T * D * 2)); \
        if (REP(5)) { xcd_barrier(bar); phase_finish(F, l); } \
        XCS(8 + 14 * (l), CS(WS_MIX, (size_t)T * D * 2)); \
        SEAM(pb + 4); \
        if (ON(6) && IN(pb + 5)) phase_gemm_out(F, a, l); \
        XCS(9 + 14 * (l), CS(WS_XL, (size_t)T * D * 4)); \
        SEAM(pb + 5); \
        if (ON(7) && IN(pb + 6)) phase_norm2(F, l); \
        SEAM(pb + 6); \
        if (ON(7) && IN(pb + 7)) phase_rgemm(F, l); \
        if (REP(7)) { xcd_barrier(bar); phase_rgemm(F, l); } \
        SEAM(pb + 7); \
        if (ON(7) && IN(pb + 8)) phase_topk(F, l); \
        XCS(10 + 14 * (l), CS(WS_EIDX, (size_t)T * 8 * 4) CS(WS_WSLOT, (size_t)T * 8 * 4)); \
        SEAM(pb + 8); \
        if (ON(7) && IN(pb + 9)) phase_lists(F, l); \
        if (REP(10)) { xcd_barrier(bar); phase_lists(F, l); } \
        XCS(11 + 14 * (l), CS(CTL_CNT, 2048)); \
        SEAM(pb + 9); \
        if (ON(8) && IN(pb + 10)) DBGRUN(10 * (l) + 4, phase_moe1(F, l), CS(WS_GSH, (size_t)T * 256 * 2)); \
        if (REP(8)) { xcd_barrier(bar); phase_moe1(F, l); } \
        XCS(12 + 14 * (l), CS(WS_GSH, (size_t)T * 256 * 2) CS(WS_G, (size_t)T * 8 * 256 * 2)); \
        SEAM(pb + 10); \
        if (ON(9) && IN(pb + 11)) DBGRUN(10 * (l) + 5, phase_moe2(F, l), CS(WS_Y, (size_t)T * 8 * D * 2) CS(WS_YSH, (size_t)T * D * 2)); \
        if (REP(9)) { xcd_barrier(bar); phase_moe2(F, l); } \
        XCS(13 + 14 * (l), CS(WS_Y, (size_t)T * 8 * D * 2) CS(WS_YSH, (size_t)T * D * 2)); \
        SEAM(pb + 11); } while (0)
    LAYER(0);
    LAYER(1);
#undef LAYER
    if (ON(10) && IN(25)) phase_norm1(F, 2);
#if MK_DEBUG == 2
    xcd_barrier(bar);
    { float ss = 0.f; for (size_t i = (size_t)F.bid * NTHR + F.tid; i < (size_t)NB * SEQ * D; i += (size_t)F.G * NTHR) ss += a.out[i] * a.out[i];
      ss = wsum(ss, F.lane); if (F.lane == 0) atomicAdd((float*)(a.ws + CTL_DBG + 63 * 8), ss); }
    xcd_barrier(bar);
    if (F.bid == 0 && F.tid == 0) { const unsigned long long* dbg = (const unsigned long long*)(a.ws + CTL_DBG); unsigned long long* prev = (unsigned long long*)(a.ws + WS_END);
        int bad = 0; const bool have = prev[63] == 0x600DF00D12345678ull; const unsigned long long nl = have ? prev[62] : 0ull;
        for (int i = 31; i >= 1; --i) { if (have && nl >= 2ull && prev[i] != dbg[i]) bad = i; prev[i] = dbg[i]; }
        prev[63] = 0x600DF00D12345678ull; prev[62] = nl + 1ull;
        if (bad) a.out[0] = 0.1f * (float)bad * sqrtf(*(const float*)(a.ws + CTL_DBG + 63 * 8)); }
#endif
#if MK_DEBUG == 3
    xcd_barrier(bar);
    if (F.bid == 0 && F.tid == 0) { const unsigned long long* dbg = (const unsigned long long*)(a.ws + CTL_DBG);
        if (dbg[0] != dbg[1]) a.out[0] = 1000.f; if (dbg[4] != dbg[5]) a.out[1] = 3000.f; }
#endif
#if MK_DEBUG == 1
    xcd_barrier(bar);
    if (F.bid == 0 && F.tid == 0) { const unsigned long long* dbg = (const unsigned long long*)(a.ws + CTL_DBG); int bad = 0;
        for (int i = 15; i >= 0; --i) if (dbg[2 * i] != dbg[2 * i + 1]) bad = i + 1;
        if (bad) a.out[0] = 1000.f * (float)bad; }
#endif
#undef IN
#undef SEAM
}

extern "C" void kernel_launch(void* const* d_in, const int* in_sizes, int n_in, void* d_out, int out_size, void* d_ws, size_t ws_size, hipStream_t stream) {
    static int grid = 0;
    if (grid == 0) {
        if (n_in != 33 || ws_size < WS_END) { fprintf(stderr, "kernel_launch: n_in %d (want 33), ws %zu (want >= %zu)\n", n_in, ws_size, (size_t)WS_END); grid = -1; return; }
        int dev = 0, cus = 0, per_cu = 0;
        if (hipGetDevice(&dev) != hipSuccess || hipDeviceGetAttribute(&cus, hipDeviceAttributeMultiprocessorCount, dev) != hipSuccess) { grid = -1; return; }
        if (hipFuncSetAttribute((const void*)fwd, hipFuncAttributeMaxDynamicSharedMemorySize, LDS_BYTES) != hipSuccess) { fprintf(stderr, "kernel_launch: hipFuncSetAttribute failed\n"); grid = -1; return; }
        if (hipOccupancyMaxActiveBlocksPerMultiprocessor(&per_cu, (const void*)fwd, NTHR, LDS_BYTES) != hipSuccess || per_cu < 1) fprintf(stderr, "kernel_launch: occupancy query says %d\n", per_cu);
        (void)hipGetLastError();
        grid = cus & ~7;
    }
    if (grid < 0) return;
    (void)hipMemsetAsync((char*)d_ws + WS_CTL, 0, CTL_BYTES, stream);
    Args a{};
    for (int i = 0; i < 33; ++i) a.in[i] = (const float*)d_in[i];
    a.out = (float*)d_out; a.ws = (unsigned char*)d_ws;
#if MK_PER_PHASE
    for (int k = 0; k < NPH; ++k) { a.ph_lo = k; a.ph_hi = k + 1; hipLaunchKernelGGL(fwd, dim3(grid), dim3(NTHR), LDS_BYTES, stream, a); }
#else
    a.ph_lo = 0; a.ph_hi = NPH; hipLaunchKernelGGL(fwd, dim3(grid), dim3(NTHR), LDS_BYTES, stream, a);
#endif
    const hipError_t le = hipPeekAtLastError();
    if (le != hipSuccess) fprintf(stderr, "kernel_launch: launch failed: %s\n", hipGetErrorName(le));
}
```
